# Optimizing an MI355X kernel written in HIP

```python
import jax, jax.numpy as jnp
from jax import lax
import numpy as np

D_MODEL = 2048
BATCH = 4
SEQ = 4096
DEPTH = 1

N_Q_HEADS = 16
N_KV_HEADS = 4
HEAD_DIM = 64
Q_GROUP = N_Q_HEADS // N_KV_HEADS
ATTN_WIDTH = N_Q_HEADS * HEAD_DIM
KV_WIDTH = N_KV_HEADS * HEAD_DIM
WINDOW = 128
BLOCK = 128
ROPE_THETA = 500000.0
ROT_DIM = HEAD_DIM // 4
POOL_WINDOWS = (2, 4, 8, 16)
N_POOL_GROUPS = len(POOL_WINDOWS)
POOL_WIDTH = D_MODEL // 2
POOL_GROUP = POOL_WIDTH // N_POOL_GROUPS
N_BRANCHES = 2
IN_SPLITS = (POOL_WIDTH, ATTN_WIDTH, KV_WIDTH, KV_WIDTH, D_MODEL, D_MODEL)
IN_WIDTH = sum(IN_SPLITS)
D_FF = 5504
N_SUBLAYERS = 3
LN_EPS = 1e-5
DN_ALPHA = (2 * DEPTH) ** 0.25
DN_BETA = (8 * DEPTH) ** -0.25

kernel_name = "hybrid_pool_swa_macaron_deepnorm_adaln"


def layer_norm(x, g, b):
    xf = x.astype(jnp.float32)
    mu = jnp.mean(xf, axis=-1, keepdims=True)
    var = jnp.mean(jnp.square(xf - mu), axis=-1, keepdims=True)
    y = (xf - mu) * lax.rsqrt(var + LN_EPS)
    return (y * g.astype(jnp.float32) + b.astype(jnp.float32)).astype(x.dtype)


def modulate(x, shift, scale):
    return x * (1.0 + scale[:, None, :]) + shift[:, None, :]


def swiglu(u, w_gu, w_down):
    a, b = jnp.split(u @ w_gu, 2, axis=-1)
    return (jax.nn.silu(a) * b) @ w_down


def rope_partial(t, cos, sin):
    half = ROT_DIM // 2
    t1 = t[..., :half]
    t2 = t[..., half:ROT_DIM]
    c = cos[None, :, None, :].astype(t.dtype)
    s = sin[None, :, None, :].astype(t.dtype)
    return jnp.concatenate([t1 * c - t2 * s, t2 * c + t1 * s, t[..., ROT_DIM:]], axis=-1)


def pool_mixer(xp, w_pool, pool_scale):
    B, S, _ = xp.shape
    groups = xp.reshape(B, S, N_POOL_GROUPS, POOL_GROUP)
    t1 = jnp.arange(S) + 1
    outs = []
    for gi, w in enumerate(POOL_WINDOWS):
        xg = groups[:, :, gi, :].astype(jnp.float32)
        cs = jnp.cumsum(xg, axis=1)
        lag = jnp.pad(cs, ((0, 0), (w, 0), (0, 0)))[:, :S]
        count = jnp.minimum(t1, w).astype(jnp.float32)[None, :, None]
        outs.append((cs - lag) / count - xg)
    pooled = jnp.stack(outs, axis=2).astype(xp.dtype)
    mixed = jnp.einsum('bsgc,gcd->bsgd', pooled, w_pool)
    return mixed.reshape(B, S, POOL_WIDTH) * pool_scale


def sliding_window_attention(q, k, v, sinks):
    B, S = q.shape[0], q.shape[1]
    nb = S // BLOCK
    qb = q.reshape(B, nb, BLOCK, N_KV_HEADS, Q_GROUP, HEAD_DIM)

    def with_prev(t):
        tb = t.reshape(B, nb, BLOCK, N_KV_HEADS, HEAD_DIM)
        prev = jnp.pad(tb[:, :-1], ((0, 0), (1, 0), (0, 0), (0, 0), (0, 0)))
        return jnp.concatenate([prev, tb], axis=2)

    kw = with_prev(k)
    vw = with_prev(v)
    s = jnp.einsum('bnqhgd,bnkhd->bnhgqk', qb, kw,
                   preferred_element_type=jnp.float32) * (HEAD_DIM ** -0.5)
    qi = jnp.arange(BLOCK)[:, None]
    kj = jnp.arange(2 * BLOCK)[None, :]
    diff = qi - kj + BLOCK
    kpos = jnp.arange(nb)[:, None, None] * BLOCK - BLOCK + kj[None]
    valid = (diff >= 0)[None] & (diff < WINDOW)[None] & (kpos >= 0)
    s = jnp.where(valid[None, :, None, None], s, -1e30)
    sink = sinks.astype(jnp.float32).reshape(1, 1, N_KV_HEADS, Q_GROUP, 1, 1)
    m = jnp.maximum(jnp.max(s, axis=-1, keepdims=True), sink)
    p = jnp.exp(s - m)
    probs = p / (jnp.sum(p, axis=-1, keepdims=True) + jnp.exp(sink - m))
    o = jnp.einsum('bnhgqk,bnkhd->bnqhgd', probs.astype(v.dtype), vw)
    return o.reshape(B, S, ATTN_WIDTH)


def setup_inputs(seed: int = 0) -> dict:
    key = jax.random.key(seed)
    ks = jax.random.split(key, 24)
    f32 = jnp.float32
    L, D = DEPTH, D_MODEL

    def nrm(k, shape, std):
        return jax.random.normal(k, shape, f32) * std

    x = jax.random.normal(ks[0], (BATCH, SEQ, D), f32)
    c = jax.random.normal(ks[1], (BATCH, D), f32)
    w_ada = nrm(ks[2], (L, D, N_SUBLAYERS * 3 * D), 0.2 * D ** -0.5)
    b_ada = nrm(ks[3], (L, N_SUBLAYERS * 3 * D), 0.01)
    ln_g = 1.0 + nrm(ks[4], (L, N_SUBLAYERS, D), 0.05)
    ln_b = nrm(ks[5], (L, N_SUBLAYERS, D), 0.01)
    w_ffn1_in = nrm(ks[6], (L, D, 2 * D_FF), DN_BETA * D ** -0.5)
    w_ffn1_out = nrm(ks[7], (L, D_FF, D), DN_BETA * D_FF ** -0.5)
    w_in = jnp.concatenate([
        nrm(ks[8], (L, D, POOL_WIDTH), D ** -0.5),
        nrm(ks[9], (L, D, ATTN_WIDTH), D ** -0.5),
        nrm(ks[10], (L, D, KV_WIDTH), D ** -0.5),
        nrm(ks[11], (L, D, KV_WIDTH), DN_BETA * D ** -0.5),
        nrm(ks[12], (L, D, N_BRANCHES * D), D ** -0.5),
    ], axis=-1)
    b_in = nrm(ks[13], (L, IN_WIDTH), 0.01)
    w_pool = nrm(ks[14], (L, N_POOL_GROUPS, POOL_GROUP, POOL_GROUP), POOL_GROUP ** -0.5)
    pool_scale = 1.0 + nrm(ks[15], (L, POOL_WIDTH), 0.1)
    sinks = nrm(ks[16], (L, N_Q_HEADS), 0.5)
    w_branch_a = nrm(ks[17], (L, POOL_WIDTH, D), DN_BETA * POOL_WIDTH ** -0.5)
    w_branch_b = nrm(ks[18], (L, ATTN_WIDTH, D), DN_BETA * ATTN_WIDTH ** -0.5)
    w_out = nrm(ks[19], (L, D, D), DN_BETA * D ** -0.5)
    w_ffn2_in = nrm(ks[20], (L, D, 2 * D_FF), DN_BETA * D ** -0.5)
    w_ffn2_out = nrm(ks[21], (L, D_FF, D), DN_BETA * D_FF ** -0.5)
    return {"x": x, "c": c, "w_ada": w_ada, "b_ada": b_ada, "ln_g": ln_g, "ln_b": ln_b,
            "w_ffn1_in": w_ffn1_in, "w_ffn1_out": w_ffn1_out, "w_in": w_in, "b_in": b_in,
            "w_pool": w_pool, "pool_scale": pool_scale, "sinks": sinks,
            "w_branch_a": w_branch_a, "w_branch_b": w_branch_b, "w_out": w_out,
            "w_ffn2_in": w_ffn2_in, "w_ffn2_out": w_ffn2_out}


def reference(x, c, w_ada, b_ada, ln_g, ln_b, w_ffn1_in, w_ffn1_out, w_in, b_in, w_pool,
              pool_scale, sinks, w_branch_a, w_branch_b, w_out, w_ffn2_in, w_ffn2_out):
    B, S, D = x.shape
    pos = jnp.arange(S, dtype=jnp.float32)
    inv_freq = ROPE_THETA ** (-jnp.arange(0, ROT_DIM, 2, dtype=jnp.float32) / ROT_DIM)
    ang = pos[:, None] * inv_freq[None, :]
    cos, sin = jnp.cos(ang), jnp.sin(ang)
    split_at = list(np.cumsum(IN_SPLITS)[:-1])
    c_act = jax.nn.silu(c)

    for l in range(DEPTH):
        mod = (c_act @ w_ada[l] + b_ada[l]).reshape(B, N_SUBLAYERS, 3, D)

        u = modulate(x, mod[:, 0, 0], mod[:, 0, 1])
        y = swiglu(u, w_ffn1_in[l], w_ffn1_out[l])
        x = layer_norm(DN_ALPHA * x + 0.5 * (1.0 + mod[:, 0, 2])[:, None, :] * y,
                       ln_g[l, 0], ln_b[l, 0])

        u = modulate(x, mod[:, 1, 0], mod[:, 1, 1])
        h = u @ w_in[l] + b_in[l]
        xp, q, k, v, gl_a, gl_b = jnp.split(h, split_at, axis=-1)
        q = rope_partial(q.reshape(B, S, N_Q_HEADS, HEAD_DIM), cos, sin)
        k = rope_partial(k.reshape(B, S, N_KV_HEADS, HEAD_DIM), cos, sin)
        v = v.reshape(B, S, N_KV_HEADS, HEAD_DIM)
        y_a = pool_mixer(xp, w_pool[l], pool_scale[l]) @ w_branch_a[l]
        y_b = sliding_window_attention(q, k, v, sinks[l]) @ w_branch_b[l]
        merged = jax.nn.sigmoid(gl_a) * y_a + jax.nn.sigmoid(gl_b) * y_b
        y = merged @ w_out[l]
        x = layer_norm(DN_ALPHA * x + (1.0 + mod[:, 1, 2])[:, None, :] * y,
                       ln_g[l, 1], ln_b[l, 1])

        u = modulate(x, mod[:, 2, 0], mod[:, 2, 1])
        y = swiglu(u, w_ffn2_in[l], w_ffn2_out[l])
        x = layer_norm(DN_ALPHA * x + 0.5 * (1.0 + mod[:, 2, 2])[:, None, :] * y,
                       ln_g[l, 2], ln_b[l, 2])
    return x
```

```cpp
#include <hip/hip_runtime.h>
#include <hip/hip_cooperative_groups.h>
#include <cstdio>
#include <cstdint>
#include <cmath>
namespace cg = cooperative_groups;
#ifndef MK_ONE_LAUNCH
#define MK_ONE_LAUNCH 1
#endif
namespace pg8 {
#define PG8_LAS __attribute__((address_space(3)))
typedef unsigned short bf16_t;
typedef short bf16x8 __attribute__((ext_vector_type(8)));
typedef float f32x4 __attribute__((ext_vector_type(4)));
typedef unsigned u32x4 __attribute__((ext_vector_type(4)));
constexpr int BM = 256, BK = 64, HALF = 128, HTB = HALF * BK * 2  , STAGE_BYTES = 8 * HTB, NXCD = 8, WGM = 8;

__host__ __device__ __forceinline__ int lds_byte(int r, int c) { const int st = (r >> 4) * 2 + (c >> 5), rr = r & 15, cc = c & 31, ob = rr * 64 + cc * 2; return st * 1024 + (ob ^ (((ob >> 9) & 1) << 5)); }
__host__ __device__ __forceinline__ void stage_rc(int b, int& R, int& C) { const int st = b / 1024, sb = b % 1024, swz = sb ^ (((sb >> 9) & 1) << 5); R = (st >> 1) * 16 + swz / 64; C = (st & 1) * 32 + (swz % 64) / 2; }
__host__ __device__ __forceinline__ int perm32(int rho) { const int n = rho >> 4, i = rho & 15; return 8 * (i >> 2) + 4 * n + (i & 3); }

struct Unit { int pm, pn; };
struct Gemm { const bf16_t* A; const bf16_t* Bt; int lda, ldb, K; size_t a_pn_bytes; };

struct StaticOrder {
    int nM, nN, nwg, G, c;
    __host__ __device__ void init(int M, int N, int G_, int c_) { nM = M / BM; nN = N / BM; nwg = nM * nN; G = G_; c = c_; }
    __host__ __device__ bool next(int i, Unit& u) const {
        const long L = (long)i * G + c; if (L >= nwg) return false;
        int wgid = (int)L; { const int q = nwg / NXCD, r = nwg % NXCD, xcd = wgid % NXCD, off = wgid / NXCD; wgid = (xcd < r ? xcd * (q + 1) : r * (q + 1) + (xcd - r) * q) + off; }
        const int nig = WGM * nN, gid = wgid / nig, fm = gid * WGM, gsz = (nM - fm) < WGM ? (nM - fm) : WGM;
        u.pm = fm + ((wgid % nig) % gsz); u.pn = (wgid % nig) / gsz; return true;
    }
    __device__ __forceinline__ void a_ready(const Unit&) const {}
    __device__ __forceinline__ void done(const Unit&) const {}
};


template <class Epi, class Sched, bool ALIGN_EPI = false, bool SP2 = false>
__device__ __forceinline__ void gemm_phase(PG8_LAS unsigned char* lds, const Gemm g, const Sched& S, const Epi& E) {
    const int tid = threadIdx.x, wid = __builtin_amdgcn_readfirstlane(tid >> 6), lane = tid & 63, wr = wid >> 2, wc = wid & 3, fr = lane & 15, fq = lane >> 4;
    const int K = g.K, nt = K / BK;
    unsigned voffA[2], voffB[2];
#pragma unroll
    for (int i = 0; i < 2; ++i) { int R, C; stage_rc(tid * 16 + i * 8192, R, C); const int Rb = Epi::PERM ? ((R & ~31) + perm32(R & 31)) : R;
        voffA[i] = (unsigned)(R * g.lda + C) * 2u; voffB[i] = (unsigned)(Rb * g.ldb + C) * 2u; }
    const size_t kstep = (size_t)(BK * 2);
    const size_t hstepA = (size_t)HALF * g.lda * 2, hstepB = (size_t)HALF * g.ldb * 2;
    const size_t tstepA = 2 * hstepA, tstepB = 2 * hstepB;
    const unsigned ldsw = (unsigned)wid * 1024u;
    const int aoff = lds_byte(wr * 64 + fr, fq * 8), boff = lds_byte(wc * 32 + fr, fq * 8);
#define PG8_SA(b, h) (((b) * 2 + (h)) * HTB)
#define PG8_SB(b, h) ((4 + (b) * 2 + (h)) * HTB)
#define PG8_STAGE(bufoff, gbase, voff) do { _Pragma("unroll") for (int _i = 0; _i < 2; ++_i) \
        __builtin_amdgcn_global_load_lds((const unsigned*)((const char*)(gbase) + (voff)[_i]), (PG8_LAS unsigned*)(lds + (bufoff) + ldsw + _i * 8192), 16, 0, 0); } while (0)
#define PG8_LDA(dst, b, h) do { _Pragma("unroll") for (int m = 0; m < 4; ++m) _Pragma("unroll") for (int k = 0; k < 2; ++k) dst[m][k] = *(const PG8_LAS bf16x8*)(lds + PG8_SA(b, h) + aoff + m * 2048 + k * 1024); } while (0)
#define PG8_LDB(dst, b, h) do { _Pragma("unroll") for (int n = 0; n < 2; ++n) _Pragma("unroll") for (int k = 0; k < 2; ++k) dst[n][k] = *(const PG8_LAS bf16x8*)(lds + PG8_SB(b, h) + boff + n * 2048 + k * 1024); } while (0)
#define PG8_MMA(ai, bj, At, Bt) do { __builtin_amdgcn_s_setprio(1); _Pragma("unroll") for (int m = 0; m < 4; ++m) _Pragma("unroll") for (int n = 0; n < 2; ++n) _Pragma("unroll") for (int k = 0; k < 2; ++k) \
        acc[ai][bj][m][n] = __builtin_amdgcn_mfma_f32_16x16x32_bf16(Bt[n][k], At[m][k], acc[ai][bj][m][n], 0, 0, 0); __builtin_amdgcn_s_setprio(0); } while (0)
#define PG8_WAIT_V(n) asm volatile("s_waitcnt vmcnt(" #n ")" ::: "memory")
#define PG8_WAIT_L(n) asm volatile("s_waitcnt lgkmcnt(" #n ")" ::: "memory")
#define PG8_BAR __builtin_amdgcn_s_barrier()
#define PG8_SCHED __builtin_amdgcn_sched_barrier(0)
    Unit cur, nxt; int ui = 0;
    if (!S.next(0, cur)) return;
    f32x4 acc[2][2][4][2];
#pragma unroll
    for (int a = 0; a < 2; ++a)
#pragma unroll
        for (int b = 0; b < 2; ++b)
#pragma unroll
            for (int m = 0; m < 4; ++m)
#pragma unroll
                for (int n = 0; n < 2; ++n) acc[a][b][m][n] = (f32x4){0.f, 0.f, 0.f, 0.f};
    bf16x8 At[4][2], B0[2][2], B1[2][2];
    const char* cA = (const char*)g.A + (size_t)cur.pm * tstepA + (size_t)cur.pn * g.a_pn_bytes; const char* cB = (const char*)g.Bt + (size_t)cur.pn * tstepB;
    S.a_ready(cur);
    if constexpr (SP2) {
        PG8_STAGE(PG8_SB(0, 0), cB, voffB); PG8_STAGE(PG8_SB(0, 1), cB + hstepB, voffB); PG8_STAGE(PG8_SA(0, 0), cA, voffA); PG8_STAGE(PG8_SA(0, 1), cA + hstepA, voffA);
        if (wr == 1) PG8_BAR;
        PG8_WAIT_V(2); PG8_BAR;
        PG8_STAGE(PG8_SB(1, 0), cB + kstep, voffB); PG8_STAGE(PG8_SA(1, 0), cA + kstep, voffA); PG8_STAGE(PG8_SB(1, 1), cB + hstepB + kstep, voffB);
        PG8_WAIT_V(6); PG8_BAR;
    } else {
        PG8_STAGE(PG8_SB(0, 0), cB, voffB); PG8_STAGE(PG8_SA(0, 0), cA, voffA); PG8_STAGE(PG8_SB(0, 1), cB + hstepB, voffB); PG8_STAGE(PG8_SA(0, 1), cA + hstepA, voffA);
        if (wr == 1) PG8_BAR;
        PG8_WAIT_V(4); PG8_BAR;
        PG8_STAGE(PG8_SB(1, 0), cB + kstep, voffB); PG8_STAGE(PG8_SA(1, 0), cA + kstep, voffA); PG8_STAGE(PG8_SB(1, 1), cB + hstepB + kstep, voffB);
        PG8_WAIT_V(6); PG8_BAR;
    }
    for (;;) {
        const bool has_next = S.next(ui + 1, nxt);
        const char* nA = has_next ? (const char*)g.A + (size_t)nxt.pm * tstepA + (size_t)nxt.pn * g.a_pn_bytes : cA; const char* nB = has_next ? (const char*)g.Bt + (size_t)nxt.pn * tstepB : cB;
        for (int t = 0; t < nt; t += 2) {
            const bool last = (t == nt - 2);
            const char* a1 = cA + (size_t)(t + 1) * kstep;
            const char* a2 = last ? nA : cA + (size_t)(t + 2) * kstep; const char* b2 = last ? nB : cB + (size_t)(t + 2) * kstep;
            const char* a3 = a2 + kstep; const char* b3 = b2 + kstep;
            if (last && has_next) S.a_ready(nxt);
            if constexpr (SP2) {
            PG8_LDB(B0, 0, 0); PG8_LDB(B1, 0, 1); PG8_SCHED; PG8_LDA(At, 0, 0); PG8_STAGE(PG8_SA(1, 1), a1 + hstepA, voffA);
            PG8_WAIT_V(8); PG8_WAIT_L(0); PG8_BAR; PG8_MMA(0, 0, At, B0); PG8_MMA(0, 1, At, B1); PG8_BAR; PG8_SCHED;
            PG8_LDA(At, 0, 1); PG8_STAGE(PG8_SB(0, 0), b2, voffB); PG8_STAGE(PG8_SB(0, 1), b2 + hstepB, voffB); PG8_STAGE(PG8_SA(0, 0), a2, voffA);
            PG8_WAIT_V(8); PG8_WAIT_L(0); PG8_BAR; PG8_MMA(1, 0, At, B0); PG8_MMA(1, 1, At, B1); PG8_BAR; PG8_SCHED;
            PG8_LDB(B0, 1, 0); PG8_LDB(B1, 1, 1); PG8_SCHED; PG8_LDA(At, 1, 0); PG8_STAGE(PG8_SA(0, 1), a2 + hstepA, voffA);
            PG8_WAIT_V(8); PG8_WAIT_L(0); PG8_BAR; PG8_MMA(0, 0, At, B0); PG8_MMA(0, 1, At, B1); PG8_BAR; PG8_SCHED;
            PG8_LDA(At, 1, 1); PG8_STAGE(PG8_SB(1, 0), b3, voffB); PG8_STAGE(PG8_SB(1, 1), b3 + hstepB, voffB); PG8_STAGE(PG8_SA(1, 0), a3, voffA);
            PG8_WAIT_V(8); PG8_WAIT_L(0); PG8_BAR; PG8_MMA(1, 0, At, B0); PG8_MMA(1, 1, At, B1); PG8_BAR; PG8_SCHED;
            } else {
            PG8_LDB(B0, 0, 0); PG8_SCHED; PG8_LDA(At, 0, 0); PG8_STAGE(PG8_SA(1, 1), a1 + hstepA, voffA);
            PG8_WAIT_L(8); PG8_BAR; PG8_WAIT_L(0); PG8_MMA(0, 0, At, B0); PG8_BAR; PG8_SCHED;
            PG8_LDB(B1, 0, 1); PG8_STAGE(PG8_SB(0, 0), b2, voffB);
            PG8_BAR; PG8_WAIT_L(0); PG8_MMA(0, 1, At, B1); PG8_BAR;
            PG8_LDA(At, 0, 1); PG8_STAGE(PG8_SA(0, 0), a2, voffA);
            PG8_BAR; PG8_WAIT_L(0); PG8_MMA(1, 0, At, B0); PG8_BAR; PG8_SCHED;
            PG8_STAGE(PG8_SB(0, 1), b2 + hstepB, voffB);
            PG8_WAIT_V(6); PG8_BAR; PG8_MMA(1, 1, At, B1); PG8_BAR;
            PG8_LDB(B0, 1, 0); PG8_SCHED; PG8_LDA(At, 1, 0); PG8_STAGE(PG8_SA(0, 1), a2 + hstepA, voffA);
            PG8_WAIT_L(8); PG8_BAR; PG8_WAIT_L(0); PG8_MMA(0, 0, At, B0); PG8_BAR; PG8_SCHED;
            PG8_LDB(B1, 1, 1); PG8_STAGE(PG8_SB(1, 0), b3, voffB);
            PG8_BAR; PG8_WAIT_L(0); PG8_MMA(0, 1, At, B1); PG8_BAR;
            PG8_LDA(At, 1, 1); PG8_STAGE(PG8_SA(1, 0), a3, voffA);
            PG8_BAR; PG8_WAIT_L(0); PG8_MMA(1, 0, At, B0); PG8_BAR; PG8_SCHED;
            PG8_STAGE(PG8_SB(1, 1), b3 + hstepB, voffB);
            PG8_WAIT_V(6); PG8_BAR; PG8_MMA(1, 1, At, B1); PG8_BAR;
            }
        }
        if constexpr (ALIGN_EPI) { if (wr == 0) PG8_BAR; }
        if constexpr (!Epi::AFTER_DRAIN) { E(acc, cur, wr, wc, fr, fq); S.done(cur); }
        if (!has_next) break;
#pragma unroll
        for (int a = 0; a < 2; ++a)
#pragma unroll
            for (int b = 0; b < 2; ++b)
#pragma unroll
                for (int m = 0; m < 4; ++m)
#pragma unroll
                    for (int n = 0; n < 2; ++n) acc[a][b][m][n] = (f32x4){0.f, 0.f, 0.f, 0.f};
        cur = nxt; cA = nA; cB = nB; ++ui;
        if constexpr (ALIGN_EPI) { if (wr == 1) PG8_BAR; }
    }
    PG8_WAIT_V(0);
    if constexpr (!ALIGN_EPI) { if (wr == 0) PG8_BAR; }
    PG8_BAR;
    if constexpr (Epi::AFTER_DRAIN) { E.fused(acc, cur, wr, wc, fr, fq, lds, wid, lane); S.done(cur); }
#undef PG8_SA
#undef PG8_SB
#undef PG8_STAGE
#undef PG8_LDA
#undef PG8_LDB
#undef PG8_MMA
#undef PG8_WAIT_V
#undef PG8_WAIT_L
#undef PG8_BAR
#undef PG8_SCHED
}
}

namespace mk {
using pg8::bf16_t; using pg8::f32x4; using pg8::u32x4; using pg8::bf16x8; using pg8::Unit;
#define LAS __attribute__((address_space(3)))
typedef float f32x16 __attribute__((ext_vector_type(16)));
typedef short s16x4 __attribute__((ext_vector_type(4)));
typedef unsigned u32x2 __attribute__((ext_vector_type(2)));
typedef __bf16 bf16x2_t __attribute__((ext_vector_type(2)));
typedef float f32x2_t __attribute__((ext_vector_type(2)));

constexpr int D = 2048, BATCH = 4, SEQ = 4096, M = BATCH * SEQ, DFF = 5504, NGU = 2 * DFF, INW = 6656, PW = 1024, AW = 1024, KVW = 256, NMOD = 9 * D;
constexpr float ALPHA = 1.189207115002721f;
constexpr float LN_EPS = 1e-5f, LOG2E = 1.4426950408889634f;
constexpr int NWAVES = 8, NTHREADS = 512;
constexpr int LDS_BYTES = 147456;

constexpr size_t MiB = 1u << 20;
constexpr size_t WS_MOD = 0;
constexpr size_t WS_ROPE = 512 * 1024;
constexpr size_t WS_WGU1 = 2 * MiB;
constexpr size_t WS_WD1 = WS_WGU1 + 43 * MiB;
constexpr size_t WS_WGU2 = WS_WD1 + 22 * MiB;
constexpr size_t WS_WD2 = WS_WGU2 + 43 * MiB;
constexpr size_t WS_WIN = WS_WD2 + 22 * MiB;
constexpr size_t WS_WP = WS_WIN + 26 * MiB;
constexpr size_t WS_WA = WS_WP + 1 * MiB;
constexpr size_t WS_WB = WS_WA + 4 * MiB;
constexpr size_t WS_WO = WS_WB + 4 * MiB;
constexpr size_t WS_U = WS_WO + 8 * MiB;
constexpr size_t WS_BIG = WS_U + 64 * MiB;
constexpr size_t WS_XP = WS_BIG, WS_Q = WS_XP + 32 * MiB, WS_K = WS_Q + 32 * MiB, WS_V = WS_K + 8 * MiB, WS_POOLED = WS_V + 8 * MiB, WS_MIXED = WS_POOLED + 32 * MiB, WS_O = WS_MIXED + 32 * MiB;
constexpr size_t WS_SGA = WS_BIG + 176 * MiB;
constexpr size_t WS_SGB = WS_SGA + 64 * MiB;
constexpr size_t WS_END = WS_SGB + 64 * MiB;
static_assert(WS_O + 32 * MiB <= WS_SGA && (size_t)M * DFF * 2 <= 176 * MiB && (size_t)D * DFF * 2 <= 22 * MiB, "ws map");

__device__ __forceinline__ unsigned pk_bf16(float lo, float hi) { f32x2_t v = {lo, hi}; bf16x2_t b = __builtin_convertvector(v, bf16x2_t); return __builtin_bit_cast(unsigned, b); }
__device__ __forceinline__ float bf_lo(unsigned w) { return __builtin_bit_cast(float, w << 16); }
__device__ __forceinline__ float bf_hi(unsigned w) { return __builtin_bit_cast(float, w & 0xffff0000u); }
__device__ __forceinline__ float sigmoid_f(float a) { return __builtin_amdgcn_rcpf(1.0f + __builtin_amdgcn_exp2f(-LOG2E * a)); }
__device__ __forceinline__ float silu_f(float a) { return a * sigmoid_f(a); }
__device__ __forceinline__ u32x4 pk8(const f32x4 v0, const f32x4 v1) { u32x4 w; w.x = pk_bf16(v0[0], v0[1]); w.y = pk_bf16(v0[2], v0[3]); w.z = pk_bf16(v1[0], v1[1]); w.w = pk_bf16(v1[2], v1[3]); return w; }

struct EpiSwiglu {
    static constexpr bool PERM = true, AFTER_DRAIN = false;
    bf16_t* H;
    __device__ __forceinline__ void operator()(const f32x4 (&acc)[2][2][4][2], const Unit& u, int wr, int wc, int fr, int fq) const {
        const int row0 = u.pm * 256 + wr * 64 + fr, col0 = u.pn * 128 + wc * 32 + 8 * fq;
#pragma unroll
        for (int ai = 0; ai < 2; ++ai)
#pragma unroll
            for (int m = 0; m < 4; ++m) { bf16_t* rowp = H + (size_t)(row0 + ai * 128 + m * 16) * DFF + col0;
                f32x4 h0, h1;
#pragma unroll
                for (int e = 0; e < 4; ++e) { h0[e] = silu_f(acc[ai][0][m][0][e]) * acc[ai][1][m][0][e]; h1[e] = silu_f(acc[ai][0][m][1][e]) * acc[ai][1][m][1][e]; }
                *(u32x4*)rowp = pk8(h0, h1); }
    }
};
struct EpiResid {
    static constexpr bool PERM = false, AFTER_DRAIN = false;
    const float* xin; float* zout; const float* gate; float w;
    __device__ __forceinline__ void operator()(const f32x4 (&acc)[2][2][4][2], const Unit& u, int wr, int wc, int fr, int fq) const {
        const int row0 = u.pm * 256 + wr * 64 + fr, col0 = u.pn * 256 + wc * 32 + 4 * fq;
        const float* gp = gate + (size_t)(u.pm >> 4) * NMOD + col0;
        f32x4 gv[2][2];
#pragma unroll
        for (int bj = 0; bj < 2; ++bj)
#pragma unroll
            for (int n = 0; n < 2; ++n) gv[bj][n] = (*(const f32x4*)(gp + bj * 128 + n * 16) + 1.0f) * w;
#pragma unroll
        for (int ai = 0; ai < 2; ++ai)
#pragma unroll
            for (int m = 0; m < 4; ++m) { const size_t off = (size_t)(row0 + ai * 128 + m * 16) * D + col0;
#pragma unroll
                for (int bj = 0; bj < 2; ++bj)
#pragma unroll
                    for (int n = 0; n < 2; ++n) { const f32x4 xv = *(const f32x4*)(xin + off + bj * 128 + n * 16);
                        *(f32x4*)(zout + off + bj * 128 + n * 16) = xv * ALPHA + gv[bj][n] * acc[ai][bj][m][n]; }
                asm volatile("" ::: "memory"); }
    }
};
struct EpiInProj {
    static constexpr bool PERM = true, AFTER_DRAIN = false;
    const float* bias; const float* rope; bf16_t *XP, *Q, *Kb, *Vb, *SGA, *SGB;
    __device__ __forceinline__ void operator()(const f32x4 (&acc)[2][2][4][2], const Unit& u, int wr, int wc, int fr, int fq) const {
        const int pn = u.pn; bf16_t* base; int ld, colt, mode; float sc = 1.f;
        if (pn < 4) { base = XP; ld = PW; colt = pn * 256; mode = 0; }
        else if (pn < 8) { base = Q; ld = AW; colt = (pn - 4) * 256; mode = 1; sc = 0.125f; }
        else if (pn == 8) { base = Kb; ld = KVW; colt = 0; mode = 1; }
        else if (pn == 9) { base = Vb; ld = KVW; colt = 0; mode = 0; }
        else if (pn < 18) { base = SGA; ld = D; colt = (pn - 10) * 256; mode = 2; }
        else { base = SGB; ld = D; colt = (pn - 18) * 256; mode = 2; }
        const int row0 = u.pm * 256 + wr * 64 + fr, col0 = colt + wc * 32 + 8 * fq, bcol0 = pn * 256 + wc * 32 + 8 * fq;
        f32x4 bv[2][2];
#pragma unroll
        for (int bj = 0; bj < 2; ++bj)
#pragma unroll
            for (int n = 0; n < 2; ++n) bv[bj][n] = *(const f32x4*)(bias + bcol0 + bj * 128 + 4 * n);
        const bool dorope = (mode == 1) && ((wc & 1) == 0);
        const float sg = (fq == 0) ? -1.f : 1.f;
#pragma unroll
        for (int ai = 0; ai < 2; ++ai)
#pragma unroll
            for (int m = 0; m < 4; ++m) { const int row = row0 + ai * 128 + m * 16;
                f32x4 c0 = {1.f, 1.f, 1.f, 1.f}, c1 = c0, s0 = {0.f, 0.f, 0.f, 0.f}, s1 = s0;
                if (dorope && fq < 2) { const float* rp = rope + (size_t)(row & (SEQ - 1)) * 16; c0 = *(const f32x4*)rp; c1 = *(const f32x4*)(rp + 4); s0 = *(const f32x4*)(rp + 8) * sg; s1 = *(const f32x4*)(rp + 12) * sg; }
#pragma unroll
                for (int bj = 0; bj < 2; ++bj) { f32x4 v0 = acc[ai][bj][m][0] + bv[bj][0], v1 = acc[ai][bj][m][1] + bv[bj][1];
                    if (dorope) { f32x4 p0, p1;
#pragma unroll
                        for (int e = 0; e < 4; ++e) { p0[e] = __shfl_xor(v0[e], 16); p1[e] = __shfl_xor(v1[e], 16); }
                        v0 = v0 * c0 + p0 * s0; v1 = v1 * c1 + p1 * s1; }
                    if (mode == 2) {
#pragma unroll
                        for (int e = 0; e < 4; ++e) { v0[e] = sigmoid_f(v0[e]); v1[e] = sigmoid_f(v1[e]); } }
                    v0 = v0 * sc; v1 = v1 * sc;
                    *(u32x4*)(base + (size_t)row * ld + col0 + bj * 128) = pk8(v0, v1); } }
    }
};
struct EpiPool {
    static constexpr bool PERM = true, AFTER_DRAIN = false;
    bf16_t* O; const float* scale;
    __device__ __forceinline__ void operator()(const f32x4 (&acc)[2][2][4][2], const Unit& u, int wr, int wc, int fr, int fq) const {
        const int row0 = u.pm * 256 + wr * 64 + fr, col0 = u.pn * 256 + wc * 32 + 8 * fq;
        f32x4 sv[2][2];
#pragma unroll
        for (int bj = 0; bj < 2; ++bj)
#pragma unroll
            for (int n = 0; n < 2; ++n) sv[bj][n] = *(const f32x4*)(scale + col0 + bj * 128 + 4 * n);
#pragma unroll
        for (int ai = 0; ai < 2; ++ai)
#pragma unroll
            for (int m = 0; m < 4; ++m) { bf16_t* rowp = O + (size_t)(row0 + ai * 128 + m * 16) * PW + col0;
#pragma unroll
                for (int bj = 0; bj < 2; ++bj) *(u32x4*)(rowp + bj * 128) = pk8(acc[ai][bj][m][0] * sv[bj][0], acc[ai][bj][m][1] * sv[bj][1]); }
    }
};
template <int MODE> struct EpiGate {
    static constexpr bool PERM = true, AFTER_DRAIN = false;
    bf16_t* G; const bf16_t* YA; bf16_t* OUT;
    __device__ __forceinline__ void operator()(const f32x4 (&acc)[2][2][4][2], const Unit& u, int wr, int wc, int fr, int fq) const {
        const int row0 = u.pm * 256 + wr * 64 + fr, col0 = u.pn * 256 + wc * 32 + 8 * fq;
#pragma unroll
        for (int ai = 0; ai < 2; ++ai)
#pragma unroll
            for (int m = 0; m < 4; ++m) { const size_t off = (size_t)(row0 + ai * 128 + m * 16) * D + col0;
#pragma unroll
                for (int bj = 0; bj < 2; ++bj) { const u32x4 gw = *(const u32x4*)(G + off + bj * 128);
                    f32x4 v0 = {bf_lo(gw.x), bf_hi(gw.x), bf_lo(gw.y), bf_hi(gw.y)}, v1 = {bf_lo(gw.z), bf_hi(gw.z), bf_lo(gw.w), bf_hi(gw.w)};
                    v0 = v0 * acc[ai][bj][m][0]; v1 = v1 * acc[ai][bj][m][1];
                    if (MODE == 1) { const u32x4 yw = *(const u32x4*)(YA + off + bj * 128);
                        v0 += (f32x4){bf_lo(yw.x), bf_hi(yw.x), bf_lo(yw.y), bf_hi(yw.y)}; v1 += (f32x4){bf_lo(yw.z), bf_hi(yw.z), bf_lo(yw.w), bf_hi(yw.w)};
                        *(u32x4*)(OUT + off + bj * 128) = pk8(v0, v1); }
                    else *(u32x4*)(G + off + bj * 128) = pk8(v0, v1); }
                asm volatile("" ::: "memory"); }
    }
};

#define MFMA32(a, b, c) __builtin_amdgcn_mfma_f32_32x32x16_bf16((a), (b), (c), 0, 0, 0)
constexpr int KS_PITCH = 144, VT_PITCH = 260  , ATT_VT_OFF = 256 * KS_PITCH;
__device__ __forceinline__ void attn_phase(LAS unsigned char* lds, const bf16_t* Q, const bf16_t* Kb, const bf16_t* Vb, bf16_t* O, const float* sinks, int G, int bid) {
    const int tid = threadIdx.x, lane = tid & 63, wid = __builtin_amdgcn_readfirstlane(tid >> 6), r = lane & 31, h = lane >> 5;
    LAS unsigned char* Ks = lds;
    LAS bf16_t* Vt = (LAS bf16_t*)(lds + ATT_VT_OFF);
    const int rg = wid & 3, hp = wid >> 2;
    for (int item = bid; item < BATCH * 4 * 32; item += G) {
        const int qblk = item & 31, kvh = (item >> 5) & 3, b = item >> 7;
        const long tokbase = (long)b * SEQ + qblk * 128 - 128;
#pragma unroll
        for (int i = 0; i < 4; ++i) { const int cid = tid + 512 * i;
            { const int key = cid >> 3, part = cid & 7; u32x4 v = {0u, 0u, 0u, 0u};
              if (qblk > 0 || key >= 128) v = *(const u32x4*)(Kb + (size_t)(tokbase + key) * KVW + kvh * 64 + part * 8);
              *(LAS u32x4*)(Ks + key * KS_PITCH + part * 16) = v; }
            { const int key = cid & 255, part = cid >> 8; u32x4 v = {0u, 0u, 0u, 0u};
              if (qblk > 0 || key >= 128) v = *(const u32x4*)(Vb + (size_t)(tokbase + key) * KVW + kvh * 64 + part * 8);
              LAS bf16_t* vp = Vt + (part * 8) * VT_PITCH + key;
              vp[0 * VT_PITCH] = (bf16_t)(v.x & 0xffffu); vp[1 * VT_PITCH] = (bf16_t)(v.x >> 16); vp[2 * VT_PITCH] = (bf16_t)(v.y & 0xffffu); vp[3 * VT_PITCH] = (bf16_t)(v.y >> 16);
              vp[4 * VT_PITCH] = (bf16_t)(v.z & 0xffffu); vp[5 * VT_PITCH] = (bf16_t)(v.z >> 16); vp[6 * VT_PITCH] = (bf16_t)(v.w & 0xffffu); vp[7 * VT_PITCH] = (bf16_t)(v.w >> 16); }
        }
        __syncthreads();
#pragma unroll 1
        for (int hh = 0; hh < 2; ++hh) {
            const int qh = kvh * 4 + hp * 2 + hh;
            const size_t tok = (size_t)b * SEQ + qblk * 128 + 32 * rg + r;
            const float sink = sinks[qh];
            bf16x8 qf[4];
#pragma unroll
            for (int s = 0; s < 4; ++s) qf[s] = *(const bf16x8*)(Q + tok * AW + qh * 64 + 16 * s + 8 * h);
            f32x16 S[5];
            float mx = -1e30f;
#pragma unroll
            for (int t = 0; t < 5; ++t) {
                f32x16 a;
#pragma unroll
                for (int i = 0; i < 16; ++i) a[i] = 0.f;
                const LAS unsigned char* kp = Ks + (32 * (rg + t) + r) * KS_PITCH + 16 * h;
#pragma unroll
                for (int s = 0; s < 4; ++s) a = MFMA32(*(const LAS bf16x8*)(kp + 32 * s), qf[s], a);
                const bool dead = (qblk == 0) && (rg + t < 4);
#pragma unroll
                for (int i = 0; i < 16; ++i) { const int cr = (i & 3) + 8 * (i >> 2) + 4 * h;
                    bool valid = !dead; if (t == 0) valid = valid && (cr > r); if (t == 4) valid = valid && (cr <= r);
                    const float sv = valid ? a[i] : -1e30f; a[i] = sv; mx = fmaxf(mx, sv); }
                S[t] = a; __builtin_amdgcn_sched_barrier(0);
            }
            mx = fmaxf(mx, __shfl_xor(mx, 32)); mx = fmaxf(mx, sink);
            float sum = 0.f; const float mxl = mx * LOG2E;
#pragma unroll
            for (int t = 0; t < 5; ++t)
#pragma unroll
                for (int i = 0; i < 16; ++i) { const float p = __builtin_amdgcn_exp2f(S[t][i] * LOG2E - mxl); S[t][i] = p; sum += p; }
            sum += __shfl_xor(sum, 32); sum += __builtin_amdgcn_exp2f(sink * LOG2E - mxl);
            const float inv = 1.0f / sum;
            f32x16 o0, o1;
#pragma unroll
            for (int i = 0; i < 16; ++i) { o0[i] = 0.f; o1[i] = 0.f; }
#pragma unroll
            for (int t = 0; t < 5; ++t)
#pragma unroll
                for (int s2 = 0; s2 < 2; ++s2) {
                    u32x4 pw; pw.x = pk_bf16(S[t][8 * s2 + 0], S[t][8 * s2 + 1]); pw.y = pk_bf16(S[t][8 * s2 + 2], S[t][8 * s2 + 3]); pw.z = pk_bf16(S[t][8 * s2 + 4], S[t][8 * s2 + 5]); pw.w = pk_bf16(S[t][8 * s2 + 6], S[t][8 * s2 + 7]);
                    const bf16x8 pf = __builtin_bit_cast(bf16x8, pw);
                    const LAS bf16_t* vp = Vt + r * VT_PITCH + 32 * (rg + t) + 16 * s2 + 4 * h;
                    const s16x4 a0 = *(const LAS s16x4*)vp, a1 = *(const LAS s16x4*)(vp + 8), b0 = *(const LAS s16x4*)(vp + 32 * VT_PITCH), b1 = *(const LAS s16x4*)(vp + 32 * VT_PITCH + 8);
                    o0 = MFMA32(__builtin_shufflevector(a0, a1, 0, 1, 2, 3, 4, 5, 6, 7), pf, o0);
                    o1 = MFMA32(__builtin_shufflevector(b0, b1, 0, 1, 2, 3, 4, 5, 6, 7), pf, o1);
                    __builtin_amdgcn_sched_barrier(0);
                }
            bf16_t* op = O + tok * AW + qh * 64 + 4 * h;
#pragma unroll
            for (int g = 0; g < 4; ++g) {
                u32x2 w0, w1; w0.x = pk_bf16(o0[4 * g] * inv, o0[4 * g + 1] * inv); w0.y = pk_bf16(o0[4 * g + 2] * inv, o0[4 * g + 3] * inv);
                w1.x = pk_bf16(o1[4 * g] * inv, o1[4 * g + 1] * inv); w1.y = pk_bf16(o1[4 * g + 2] * inv, o1[4 * g + 3] * inv);
                *(u32x2*)(op + 8 * g) = w0; *(u32x2*)(op + 32 + 8 * g) = w1; }
        }
        __syncthreads();
    }
}

__device__ __forceinline__ void pool_phase(const bf16_t* XP, bf16_t* P, int gw, int NGW, int lane) {
    for (int it = gw; it < 2 * M; it += NGW) {
        const int row = it >> 1, c0 = (it & 1) * 512 + lane * 8, g = c0 >> 8, w = 2 << g, pos = row & (SEQ - 1);
        const int cnt = (pos + 1 < w) ? pos + 1 : w;
        const bf16_t* src = XP + (size_t)row * PW + c0;
        float a[8];
#pragma unroll
        for (int e = 0; e < 8; ++e) a[e] = 0.f;
        const u32x4 x0 = *(const u32x4*)src;
        for (int j = 1; j < cnt; ++j) { const u32x4 v = *(const u32x4*)(src - (size_t)j * PW);
            a[0] += bf_lo(v.x); a[1] += bf_hi(v.x); a[2] += bf_lo(v.y); a[3] += bf_hi(v.y); a[4] += bf_lo(v.z); a[5] += bf_hi(v.z); a[6] += bf_lo(v.w); a[7] += bf_hi(v.w); }
        const float xs[8] = {bf_lo(x0.x), bf_hi(x0.x), bf_lo(x0.y), bf_hi(x0.y), bf_lo(x0.z), bf_hi(x0.z), bf_lo(x0.w), bf_hi(x0.w)};
        const float ic = 1.0f / (float)cnt; float o[8];
#pragma unroll
        for (int e = 0; e < 8; ++e) o[e] = (a[e] + xs[e]) * ic - xs[e];
        u32x4 ow; ow.x = pk_bf16(o[0], o[1]); ow.y = pk_bf16(o[2], o[3]); ow.z = pk_bf16(o[4], o[5]); ow.w = pk_bf16(o[6], o[7]);
        *(u32x4*)(P + (size_t)row * PW + c0) = ow;
    }
}

__device__ __forceinline__ float wave_sum(float v) {
#pragma unroll
    for (int o = 1; o < 64; o <<= 1) v += __shfl_xor(v, o);
    return v;
}
template <int MODE> __device__ __forceinline__ void row_phase(const float* xin, float* xout, bf16_t* U, const float* lng, const float* lnb, const float* shift, const float* scale, int gw, int NGW, int lane) {
    for (int row = gw; row < M; row += NGW) {
        const f32x4* xr = (const f32x4*)(xin + (size_t)row * D) + lane;
        f32x4 v[8];
#pragma unroll
        for (int j = 0; j < 8; ++j) v[j] = xr[64 * j];
        if (MODE != 0) {
            float s = 0.f;
#pragma unroll
            for (int j = 0; j < 8; ++j) s += (v[j][0] + v[j][1]) + (v[j][2] + v[j][3]);
            const float mean = wave_sum(s) * (1.0f / D); float s2 = 0.f;
#pragma unroll
            for (int j = 0; j < 8; ++j) { v[j] = v[j] - mean; s2 += (v[j][0] * v[j][0] + v[j][1] * v[j][1]) + (v[j][2] * v[j][2] + v[j][3] * v[j][3]); }
            const float rstd = 1.0f / sqrtf(wave_sum(s2) * (1.0f / D) + LN_EPS);
            f32x4* xo = (f32x4*)(xout + (size_t)row * D) + lane;
#pragma unroll
            for (int j = 0; j < 8; ++j) { const f32x4 gg = *((const f32x4*)lng + lane + 64 * j), bb = *((const f32x4*)lnb + lane + 64 * j); v[j] = v[j] * rstd * gg + bb; xo[64 * j] = v[j]; }
        }
        if (MODE != 2) {
            const int b = row >> 12;
            const f32x4* sh = (const f32x4*)(shift + (size_t)b * NMOD) + lane; const f32x4* sc = (const f32x4*)(scale + (size_t)b * NMOD) + lane;
            u32x2* uo = (u32x2*)(U + (size_t)row * D) + lane;
#pragma unroll
            for (int j = 0; j < 8; ++j) { const f32x4 t = v[j] * (sc[64 * j] + 1.0f) + sh[64 * j]; u32x2 w; w.x = pk_bf16(t[0], t[1]); w.y = pk_bf16(t[2], t[3]); uo[64 * j] = w; }
        }
    }
}

__device__ __forceinline__ void transpose_item(const float* W, int K, int N, bf16_t* WT, int k0, int n0, int drow0, LAS float* scr, int lane) {
#pragma unroll 8
    for (int i = 0; i < 32; ++i) { const int kk = 2 * i + (lane >> 5); scr[kk * 33 + (lane & 31)] = W[(size_t)(k0 + kk) * N + n0 + (lane & 31)]; }
    asm volatile("s_waitcnt lgkmcnt(0)" ::: "memory");
    const int c = lane & 7;
#pragma unroll
    for (int j = 0; j < 4; ++j) { const int n = (lane >> 3) + 8 * j; const LAS float* s = scr + (8 * c) * 33 + n;
        u32x4 o; o.x = pk_bf16(s[0 * 33], s[1 * 33]); o.y = pk_bf16(s[2 * 33], s[3 * 33]); o.z = pk_bf16(s[4 * 33], s[5 * 33]); o.w = pk_bf16(s[6 * 33], s[7 * 33]);
        *(u32x4*)(WT + (size_t)(drow0 + n) * K + k0 + 8 * c) = o; }
    asm volatile("s_waitcnt lgkmcnt(0)" ::: "memory");
}
__device__ __forceinline__ void transpose_plain(const float* W, int K, int N, bf16_t* WT, int item, LAS float* scr, int lane) {
    const int nblk = N / 32, kb = item / nblk, nb = item % nblk; transpose_item(W, K, N, WT, 64 * kb, 32 * nb, 32 * nb, scr, lane);
}
__device__ __forceinline__ void transpose_gu(const float* W, bf16_t* WT, int item, LAS float* scr, int lane) {
    const int nblk = NGU / 32, kb = item / nblk, nb = item % nblk, n0 = 32 * nb, bj = n0 / DFF, rem = n0 - bj * DFF, pn = rem >> 7, i0 = rem & 127;
    transpose_item(W, D, NGU, WT, 64 * kb, n0, 256 * pn + 128 * bj + i0, scr, lane);
}

struct Args { const float* in[18]; float* out; unsigned char* ws; float inv_freq[8]; int ph_lo, ph_hi; };
constexpr int N_PHASES = 14;

__global__ void __launch_bounds__(NTHREADS, 2) fwd_kernel(Args args) {
    extern __shared__ __attribute__((aligned(16))) unsigned char lds_raw[];
    LAS unsigned char* lds = (LAS unsigned char*)lds_raw;
    const int tid = threadIdx.x, lane = tid & 63, wave = __builtin_amdgcn_readfirstlane(tid >> 6);
    const int G = gridDim.x, bid = blockIdx.x;
    const int gw = bid * NWAVES + wave, NGW = G * NWAVES;
#define x (args.in[0])
#define c (args.in[1])
#define w_ada (args.in[2])
#define b_ada (args.in[3])
#define ln_g (args.in[4])
#define ln_b (args.in[5])
#define w_ffn1_in (args.in[6])
#define w_ffn1_out (args.in[7])
#define w_in (args.in[8])
#define b_in (args.in[9])
#define w_pool (args.in[10])
#define pool_scale (args.in[11])
#define sinks (args.in[12])
#define w_branch_a (args.in[13])
#define w_branch_b (args.in[14])
#define w_out (args.in[15])
#define w_ffn2_in (args.in[16])
#define w_ffn2_out (args.in[17])
#define out (args.out)
#define WSP(T, off) ((T*)(args.ws + (off)))
#define MOD WSP(float, WS_MOD)
#define ROPE WSP(float, WS_ROPE)
#define WGU1 WSP(bf16_t, WS_WGU1)
#define WD1 WSP(bf16_t, WS_WD1)
#define WGU2 WSP(bf16_t, WS_WGU2)
#define WD2 WSP(bf16_t, WS_WD2)
#define WIN WSP(bf16_t, WS_WIN)
#define WP WSP(bf16_t, WS_WP)
#define WA WSP(bf16_t, WS_WA)
#define WB WSP(bf16_t, WS_WB)
#define WO WSP(bf16_t, WS_WO)
#define U WSP(bf16_t, WS_U)
#define MERGED WSP(bf16_t, WS_U)
#define H WSP(bf16_t, WS_BIG)
#define XP WSP(bf16_t, WS_XP)
#define Q WSP(bf16_t, WS_Q)
#define KB WSP(bf16_t, WS_K)
#define VB WSP(bf16_t, WS_V)
#define POOLED WSP(bf16_t, WS_POOLED)
#define MIXED WSP(bf16_t, WS_MIXED)
#define OB WSP(bf16_t, WS_O)
#define SGA WSP(bf16_t, WS_SGA)
#define SGB WSP(bf16_t, WS_SGB)
    const int lo = args.ph_lo, hi = args.ph_hi;
#ifndef MK_PHASES
#define MK_PHASES 0x3fff
#endif
#define IN(k) (((MK_PHASES >> (k)) & 1) && lo <= (k) && (k) < hi)
#if MK_ONE_LAUNCH
#define SEAM(k) do { if (IN(k) && IN((k) + 1)) cg::this_grid().sync(); } while (0)
#else
#define SEAM(k) do { } while (0)
#endif
#define GEMM(EPI, g, S, E) pg8::gemm_phase<EPI, pg8::StaticOrder, true, true>(lds, g, S, E)

    if (IN(0)) {
        LAS float* cact = (LAS float*)lds;
        LAS float* red = (LAS float*)(lds + 32768);
        for (int i = tid; i < BATCH * D; i += NTHREADS) cact[i] = silu_f(c[i]);
        __syncthreads();
        for (int item = bid; item < 256; item += G) {
            const int col0 = item * 72, rsub = lane / 18, cl = lane - rsub * 18;
            f32x4 a0 = {0.f, 0.f, 0.f, 0.f}, a1 = a0, a2 = a0, a3 = a0;
            if (lane < 54) {
                const float* wp = w_ada + col0 + 4 * cl;
#pragma unroll 8
                for (int k = wave * 256 + rsub; k < wave * 256 + 256; k += 3) { const f32x4 wv = *(const f32x4*)(wp + (size_t)k * NMOD);
                    a0 += wv * cact[k]; a1 += wv * cact[D + k]; a2 += wv * cact[2 * D + k]; a3 += wv * cact[3 * D + k]; }
                LAS float* rp = red + ((wave * 3 + rsub) * 4) * 72 + 4 * cl;
                *(LAS f32x4*)(rp) = a0; *(LAS f32x4*)(rp + 72) = a1; *(LAS f32x4*)(rp + 144) = a2; *(LAS f32x4*)(rp + 216) = a3;
            }
            __syncthreads();
            if (tid < 288) { const int b = tid / 72, cc = tid - b * 72; float s = b_ada[col0 + cc];
                for (int p = 0; p < 24; ++p) s += red[(p * 4 + b) * 72 + cc];
                MOD[(size_t)b * NMOD + col0 + cc] = s; }
            __syncthreads();
        }
        for (int i = bid * NTHREADS + tid; i < SEQ * 8; i += G * NTHREADS) { const int pos = i >> 3, j = i & 7; const float ang = (float)pos * args.inv_freq[j];
            ROPE[pos * 16 + j] = cosf(ang); ROPE[pos * 16 + 8 + j] = sinf(ang); }
        __syncthreads();
        LAS float* scr = (LAS float*)(lds + wave * 16384);
        constexpr int I_GU = (D / 64) * (NGU / 32), I_DN = (DFF / 64) * (D / 32), I_IN = (D / 64) * (INW / 32), I_P = 4 * 8, I_BR = (1024 / 64) * (D / 32), I_O = (D / 64) * (D / 32);
        constexpr int NITEMS = 2 * I_GU + 2 * I_DN + I_IN + 4 * I_P + 2 * I_BR + I_O;
        for (int it = gw; it < NITEMS; it += NGW) {
            int r = it;
            if (r < I_GU) { transpose_gu(w_ffn1_in, WGU1, r, scr, lane); continue; } r -= I_GU;
            if (r < I_DN) { transpose_plain(w_ffn1_out, DFF, D, WD1, r, scr, lane); continue; } r -= I_DN;
            if (r < I_IN) { transpose_plain(w_in, D, INW, WIN, r, scr, lane); continue; } r -= I_IN;
            if (r < 4 * I_P) { const int g = r / I_P; transpose_plain(w_pool + (size_t)g * 65536, 256, 256, WP + (size_t)g * 65536, r - g * I_P, scr, lane); continue; } r -= 4 * I_P;
            if (r < I_BR) { transpose_plain(w_branch_a, 1024, D, WA, r, scr, lane); continue; } r -= I_BR;
            if (r < I_BR) { transpose_plain(w_branch_b, 1024, D, WB, r, scr, lane); continue; } r -= I_BR;
            if (r < I_O) { transpose_plain(w_out, D, D, WO, r, scr, lane); continue; } r -= I_O;
            if (r < I_GU) { transpose_gu(w_ffn2_in, WGU2, r, scr, lane); continue; } r -= I_GU;
            transpose_plain(w_ffn2_out, DFF, D, WD2, r, scr, lane);
        }
        __syncthreads();
    }
    SEAM(0);
    if (IN(1)) row_phase<0>(x, nullptr, U, nullptr, nullptr, MOD + 0 * D, MOD + 1 * D, gw, NGW, lane);
    SEAM(1);
    if (IN(2)) { pg8::Gemm g{U, WGU1, D, D, D, 0}; pg8::StaticOrder S; S.init(M, NGU, G, bid); EpiSwiglu E{H}; GEMM(EpiSwiglu, g, S, E); }
    SEAM(2);
    if (IN(3)) { pg8::Gemm g{H, WD1, DFF, DFF, DFF, 0}; pg8::StaticOrder S; S.init(M, D, G, bid); EpiResid E{x, out, MOD + 2 * D, 0.5f}; GEMM(EpiResid, g, S, E); }
    SEAM(3);
    if (IN(4)) row_phase<1>(out, out, U, ln_g, ln_b, MOD + 3 * D, MOD + 4 * D, gw, NGW, lane);
    SEAM(4);
    if (IN(5)) { pg8::Gemm g{U, WIN, D, D, D, 0}; pg8::StaticOrder S; S.init(M, INW, G, bid); EpiInProj E{b_in, ROPE, XP, Q, KB, VB, SGA, SGB}; GEMM(EpiInProj, g, S, E); }
    SEAM(5);
    if (IN(6)) { attn_phase(lds, Q, KB, VB, OB, sinks, G, bid); pool_phase(XP, POOLED, gw, NGW, lane); }
    SEAM(6);
    if (IN(7)) { int kp = 256; asm volatile("" : "+s"(kp)); pg8::Gemm g{POOLED, WP, PW, 256, kp, 512}; pg8::StaticOrder S; S.init(M, PW, G, bid); EpiPool E{MIXED, pool_scale}; GEMM(EpiPool, g, S, E); }
    SEAM(7);
    if (IN(8)) {
        { pg8::Gemm g{MIXED, WA, PW, PW, PW, 0}; pg8::StaticOrder S; S.init(M, D, G, bid); EpiGate<0> E{SGA, nullptr, nullptr}; GEMM(EpiGate<0>, g, S, E); }
        { pg8::Gemm g{OB, WB, AW, AW, AW, 0}; pg8::StaticOrder S; S.init(M, D, G, bid); EpiGate<1> E{SGB, SGA, MERGED}; GEMM(EpiGate<1>, g, S, E); }
    }
    SEAM(8);
    if (IN(9)) { pg8::Gemm g{MERGED, WO, D, D, D, 0}; pg8::StaticOrder S; S.init(M, D, G, bid); EpiResid E{out, out, MOD + 5 * D, 1.0f}; GEMM(EpiResid, g, S, E); }
    SEAM(9);
    if (IN(10)) row_phase<1>(out, out, U, ln_g + D, ln_b + D, MOD + 6 * D, MOD + 7 * D, gw, NGW, lane);
    SEAM(10);
    if (IN(11)) { pg8::Gemm g{U, WGU2, D, D, D, 0}; pg8::StaticOrder S; S.init(M, NGU, G, bid); EpiSwiglu E{H}; GEMM(EpiSwiglu, g, S, E); }
    SEAM(11);
    if (IN(12)) { pg8::Gemm g{H, WD2, DFF, DFF, DFF, 0}; pg8::StaticOrder S; S.init(M, D, G, bid); EpiResid E{out, out, MOD + 8 * D, 0.5f}; GEMM(EpiResid, g, S, E); }
    SEAM(12);
    if (IN(13)) row_phase<2>(out, out, nullptr, ln_g + 2 * D, ln_b + 2 * D, nullptr, nullptr, gw, NGW, lane);
#undef IN
#undef SEAM
#undef GEMM
#undef x
#undef c
#undef w_ada
#undef b_ada
#undef ln_g
#undef ln_b
#undef w_ffn1_in
#undef w_ffn1_out
#undef w_in
#undef b_in
#undef w_pool
#undef pool_scale
#undef sinks
#undef w_branch_a
#undef w_branch_b
#undef w_out
#undef w_ffn2_in
#undef w_ffn2_out
#undef out
#undef WSP
#undef MOD
#undef ROPE
#undef WGU1
#undef WD1
#undef WGU2
#undef WD2
#undef WIN
#undef WP
#undef WA
#undef WB
#undef WO
#undef U
#undef MERGED
#undef H
#undef XP
#undef Q
#undef KB
#undef VB
#undef POOLED
#undef MIXED
#undef OB
#undef SGA
#undef SGB
}
}

extern "C" void kernel_launch(void* const* d_in, const int* in_sizes, int n_in, void* d_out, int out_size, void* d_ws, size_t ws_size, hipStream_t stream) {
    using namespace mk;
    static int grid = 0;
    if (grid == 0) {
        if (n_in != 18 || in_sizes[0] != M * D || out_size != M * D || ws_size < WS_END) { fprintf(stderr, "kernel_launch: unexpected shapes (n_in %d, in0 %d, out %d, ws %zu < %zu)\n", n_in, n_in > 0 ? in_sizes[0] : -1, out_size, ws_size, (size_t)WS_END); grid = -1; return; }
        int dev = 0, cus = 0, per_cu = 0;
        if (hipGetDevice(&dev) != hipSuccess || hipDeviceGetAttribute(&cus, hipDeviceAttributeMultiprocessorCount, dev) != hipSuccess) { grid = -1; return; }
        if (hipFuncSetAttribute((const void*)fwd_kernel, hipFuncAttributeMaxDynamicSharedMemorySize, LDS_BYTES) != hipSuccess) { fprintf(stderr, "kernel_launch: hipFuncSetAttribute failed\n"); grid = -1; return; }
        if (hipOccupancyMaxActiveBlocksPerMultiprocessor(&per_cu, (const void*)fwd_kernel, NTHREADS, LDS_BYTES) != hipSuccess || per_cu < 1) { fprintf(stderr, "kernel_launch: occupancy query says %d\n", per_cu); per_cu = 1; }
        (void)hipGetLastError();
        grid = cus * per_cu;
    }
    if (grid < 0) return;
    Args a{};
    for (int i = 0; i < 18; ++i) a.in[i] = (const float*)d_in[i];
    a.out = (float*)d_out; a.ws = (unsigned char*)d_ws;
    for (int j = 0; j < 8; ++j) a.inv_freq[j] = (float)pow(500000.0, -(double)j / 8.0);
#if MK_ONE_LAUNCH
    a.ph_lo = 0; a.ph_hi = N_PHASES;
    void* kargs[] = {&a};
    hipError_t e = hipLaunchCooperativeKernel((const void*)fwd_kernel, dim3(grid), dim3(NTHREADS), kargs, LDS_BYTES, stream);
    if (e != hipSuccess) fprintf(stderr, "kernel_launch: cooperative launch failed: %s (grid %d)\n", hipGetErrorString(e), grid);
#else
    for (int p = 0; p < N_PHASES; ++p) { a.ph_lo = p; a.ph_hi = p + 1; hipLaunchKernelGGL(fwd_kernel, dim3(grid), dim3(NTHREADS), LDS_BYTES, stream, a); }
#endif
}
```

```cpp
#include <hip/hip_runtime.h>
#include <hip/hip_cooperative_groups.h>
#include <cstdio>
#include <cstdint>
#include <cmath>
namespace cg = cooperative_groups;
#ifndef MK_ONE_LAUNCH
#define MK_ONE_LAUNCH 1
#endif
namespace pg8 {
#define PG8_LAS __attribute__((address_space(3)))
typedef unsigned short bf16_t;
typedef short bf16x8 __attribute__((ext_vector_type(8)));
typedef float f32x4 __attribute__((ext_vector_type(4)));
typedef unsigned u32x4 __attribute__((ext_vector_type(4)));
constexpr int BM = 256, BK = 64, HALF = 128, HTB = HALF * BK * 2  , STAGE_BYTES = 8 * HTB, NXCD = 8, WGM = 8;

__host__ __device__ __forceinline__ int lds_byte(int r, int c) { const int st = (r >> 4) * 2 + (c >> 5), rr = r & 15, cc = c & 31, ob = rr * 64 + cc * 2; return st * 1024 + (ob ^ (((ob >> 9) & 1) << 5)); }
__host__ __device__ __forceinline__ void stage_rc(int b, int& R, int& C) { const int st = b / 1024, sb = b % 1024, swz = sb ^ (((sb >> 9) & 1) << 5); R = (st >> 1) * 16 + swz / 64; C = (st & 1) * 32 + (swz % 64) / 2; }
__host__ __device__ __forceinline__ int perm32(int rho) { const int n = rho >> 4, i = rho & 15; return 8 * (i >> 2) + 4 * n + (i & 3); }

struct Unit { int pm, pn; };
struct Gemm { const bf16_t* A; const bf16_t* Bt; int lda, ldb, K; size_t a_pn_bytes; };

struct StaticOrder {
    int nM, nN, nwg, G, c;
    __host__ __device__ void init(int M, int N, int G_, int c_) { nM = M / BM; nN = N / BM; nwg = nM * nN; G = G_; c = c_; }
    __host__ __device__ bool next(int i, Unit& u) const {
        const long L = (long)i * G + c; if (L >= nwg) return false;
        int wgid = (int)L; { const int q = nwg / NXCD, r = nwg % NXCD, xcd = wgid % NXCD, off = wgid / NXCD; wgid = (xcd < r ? xcd * (q + 1) : r * (q + 1) + (xcd - r) * q) + off; }
        const int nig = WGM * nN, gid = wgid / nig, fm = gid * WGM, gsz = (nM - fm) < WGM ? (nM - fm) : WGM;
        u.pm = fm + ((wgid % nig) % gsz); u.pn = (wgid % nig) / gsz; return true;
    }
    __device__ __forceinline__ void a_ready(const Unit&) const {}
    __device__ __forceinline__ void done(const Unit&) const {}
};


template <class Epi, class Sched, bool ALIGN_EPI = false, bool SP2 = false>
__device__ __forceinline__ void gemm_phase(PG8_LAS unsigned char* lds, const Gemm g, const Sched& S, const Epi& E) {
    const int tid = threadIdx.x, wid = __builtin_amdgcn_readfirstlane(tid >> 6), lane = tid & 63, wr = wid >> 2, wc = wid & 3, fr = lane & 15, fq = lane >> 4;
    const int K = g.K, nt = K / BK;
    unsigned voffA[2], voffB[2];
#pragma unroll
    for (int i = 0; i < 2; ++i) { int R, C; stage_rc(tid * 16 + i * 8192, R, C); const int Rb = Epi::PERM ? ((R & ~31) + perm32(R & 31)) : R;
        voffA[i] = (unsigned)(R * g.lda + C) * 2u; voffB[i] = (unsigned)(Rb * g.ldb + C) * 2u; }
    const size_t kstep = (size_t)(BK * 2);
    const size_t hstepA = (size_t)HALF * g.lda * 2, hstepB = (size_t)HALF * g.ldb * 2;
    const size_t tstepA = 2 * hstepA, tstepB = 2 * hstepB;
    const unsigned ldsw = (unsigned)wid * 1024u;
    const int aoff = lds_byte(wr * 64 + fr, fq * 8), boff = lds_byte(wc * 32 + fr, fq * 8);
#define PG8_SA(b, h) (((b) * 2 + (h)) * HTB)
#define PG8_SB(b, h) ((4 + (b) * 2 + (h)) * HTB)
#define PG8_STAGE(bufoff, gbase, voff) do { _Pragma("unroll") for (int _i = 0; _i < 2; ++_i) \
        __builtin_amdgcn_global_load_lds((const unsigned*)((const char*)(gbase) + (voff)[_i]), (PG8_LAS unsigned*)(lds + (bufoff) + ldsw + _i * 8192), 16, 0, 0); } while (0)
#define PG8_LDA(dst, b, h) do { _Pragma("unroll") for (int m = 0; m < 4; ++m) _Pragma("unroll") for (int k = 0; k < 2; ++k) dst[m][k] = *(const PG8_LAS bf16x8*)(lds + PG8_SA(b, h) + aoff + m * 2048 + k * 1024); } while (0)
#define PG8_LDB(dst, b, h) do { _Pragma("unroll") for (int n = 0; n < 2; ++n) _Pragma("unroll") for (int k = 0; k < 2; ++k) dst[n][k] = *(const PG8_LAS bf16x8*)(lds + PG8_SB(b, h) + boff + n * 2048 + k * 1024); } while (0)
#define PG8_MMA(ai, bj, At, Bt) do { __builtin_amdgcn_s_setprio(1); _Pragma("unroll") for (int m = 0; m < 4; ++m) _Pragma("unroll") for (int n = 0; n < 2; ++n) _Pragma("unroll") for (int k = 0; k < 2; ++k) \
        acc[ai][bj][m][n] = __builtin_amdgcn_mfma_f32_16x16x32_bf16(Bt[n][k], At[m][k], acc[ai][bj][m][n], 0, 0, 0); __builtin_amdgcn_s_setprio(0); } while (0)
#define PG8_WAIT_V(n) asm volatile("s_waitcnt vmcnt(" #n ")" ::: "memory")
#define PG8_WAIT_L(n) asm volatile("s_waitcnt lgkmcnt(" #n ")" ::: "memory")
#define PG8_BAR __builtin_amdgcn_s_barrier()
#define PG8_SCHED __builtin_amdgcn_sched_barrier(0)
    Unit cur, nxt; int ui = 0;
    if (!S.next(0, cur)) return;
    f32x4 acc[2][2][4][2];
#pragma unroll
    for (int a = 0; a < 2; ++a)
#pragma unroll
        for (int b = 0; b < 2; ++b)
#pragma unroll
            for (int m = 0; m < 4; ++m)
#pragma unroll
                for (int n = 0; n < 2; ++n) acc[a][b][m][n] = (f32x4){0.f, 0.f, 0.f, 0.f};
    bf16x8 At[4][2], B0[2][2], B1[2][2];
    const char* cA = (const char*)g.A + (size_t)cur.pm * tstepA + (size_t)cur.pn * g.a_pn_bytes; const char* cB = (const char*)g.Bt + (size_t)cur.pn * tstepB;
    S.a_ready(cur);
    if constexpr (SP2) {
        PG8_STAGE(PG8_SB(0, 0), cB, voffB); PG8_STAGE(PG8_SB(0, 1), cB + hstepB, voffB); PG8_STAGE(PG8_SA(0, 0), cA, voffA); PG8_STAGE(PG8_SA(0, 1), cA + hstepA, voffA);
        if (wr == 1) PG8_BAR;
        PG8_WAIT_V(2); PG8_BAR;
        PG8_STAGE(PG8_SB(1, 0), cB + kstep, voffB); PG8_STAGE(PG8_SA(1, 0), cA + kstep, voffA); PG8_STAGE(PG8_SB(1, 1), cB + hstepB + kstep, voffB);
        PG8_WAIT_V(6); PG8_BAR;
    } else {
        PG8_STAGE(PG8_SB(0, 0), cB, voffB); PG8_STAGE(PG8_SA(0, 0), cA, voffA); PG8_STAGE(PG8_SB(0, 1), cB + hstepB, voffB); PG8_STAGE(PG8_SA(0, 1), cA + hstepA, voffA);
        if (wr == 1) PG8_BAR;
        PG8_WAIT_V(4); PG8_BAR;
        PG8_STAGE(PG8_SB(1, 0), cB + kstep, voffB); PG8_STAGE(PG8_SA(1, 0), cA + kstep, voffA); PG8_STAGE(PG8_SB(1, 1), cB + hstepB + kstep, voffB);
        PG8_WAIT_V(6); PG8_BAR;
    }
    for (;;) {
        const bool has_next = S.next(ui + 1, nxt);
        const char* nA = has_next ? (const char*)g.A + (size_t)nxt.pm * tstepA + (size_t)nxt.pn * g.a_pn_bytes : cA; const char* nB = has_next ? (const char*)g.Bt + (size_t)nxt.pn * tstepB : cB;
        for (int t = 0; t < nt; t += 2) {
            const bool last = (t == nt - 2);
            const char* a1 = cA + (size_t)(t + 1) * kstep;
            const char* a2 = last ? nA : cA + (size_t)(t + 2) * kstep; const char* b2 = last ? nB : cB + (size_t)(t + 2) * kstep;
            const char* a3 = a2 + kstep; const char* b3 = b2 + kstep;
            if (last && has_next) S.a_ready(nxt);
            if constexpr (SP2) {
            PG8_LDB(B0, 0, 0); PG8_LDB(B1, 0, 1); PG8_SCHED; PG8_LDA(At, 0, 0); PG8_STAGE(PG8_SA(1, 1), a1 + hstepA, voffA);
            PG8_WAIT_V(8); PG8_WAIT_L(0); PG8_BAR; PG8_MMA(0, 0, At, B0); PG8_MMA(0, 1, At, B1); PG8_BAR; PG8_SCHED;
            PG8_LDA(At, 0, 1); PG8_STAGE(PG8_SB(0, 0), b2, voffB); PG8_STAGE(PG8_SB(0, 1), b2 + hstepB, voffB); PG8_STAGE(PG8_SA(0, 0), a2, voffA);
            PG8_WAIT_V(8); PG8_WAIT_L(0); PG8_BAR; PG8_MMA(1, 0, At, B0); PG8_MMA(1, 1, At, B1); PG8_BAR; PG8_SCHED;
            PG8_LDB(B0, 1, 0); PG8_LDB(B1, 1, 1); PG8_SCHED; PG8_LDA(At, 1, 0); PG8_STAGE(PG8_SA(0, 1), a2 + hstepA, voffA);
            PG8_WAIT_V(8); PG8_WAIT_L(0); PG8_BAR; PG8_MMA(0, 0, At, B0); PG8_MMA(0, 1, At, B1); PG8_BAR; PG8_SCHED;
            PG8_LDA(At, 1, 1); PG8_STAGE(PG8_SB(1, 0), b3, voffB); PG8_STAGE(PG8_SB(1, 1), b3 + hstepB, voffB); PG8_STAGE(PG8_SA(1, 0), a3, voffA);
            PG8_WAIT_V(8); PG8_WAIT_L(0); PG8_BAR; PG8_MMA(1, 0, At, B0); PG8_MMA(1, 1, At, B1); PG8_BAR; PG8_SCHED;
            } else {
            PG8_LDB(B0, 0, 0); PG8_SCHED; PG8_LDA(At, 0, 0); PG8_STAGE(PG8_SA(1, 1), a1 + hstepA, voffA);
            PG8_WAIT_L(8); PG8_BAR; PG8_WAIT_L(0); PG8_MMA(0, 0, At, B0); PG8_BAR; PG8_SCHED;
            PG8_LDB(B1, 0, 1); PG8_STAGE(PG8_SB(0, 0), b2, voffB);
            PG8_BAR; PG8_WAIT_L(0); PG8_MMA(0, 1, At, B1); PG8_BAR;
            PG8_LDA(At, 0, 1); PG8_STAGE(PG8_SA(0, 0), a2, voffA);
            PG8_BAR; PG8_WAIT_L(0); PG8_MMA(1, 0, At, B0); PG8_BAR; PG8_SCHED;
            PG8_STAGE(PG8_SB(0, 1), b2 + hstepB, voffB);
            PG8_WAIT_V(6); PG8_BAR; PG8_MMA(1, 1, At, B1); PG8_BAR;
            PG8_LDB(B0, 1, 0); PG8_SCHED; PG8_LDA(At, 1, 0); PG8_STAGE(PG8_SA(0, 1), a2 + hstepA, voffA);
            PG8_WAIT_L(8); PG8_BAR; PG8_WAIT_L(0); PG8_MMA(0, 0, At, B0); PG8_BAR; PG8_SCHED;
            PG8_LDB(B1, 1, 1); PG8_STAGE(PG8_SB(1, 0), b3, voffB);
            PG8_BAR; PG8_WAIT_L(0); PG8_MMA(0, 1, At, B1); PG8_BAR;
            PG8_LDA(At, 1, 1); PG8_STAGE(PG8_SA(1, 0), a3, voffA);
            PG8_BAR; PG8_WAIT_L(0); PG8_MMA(1, 0, At, B0); PG8_BAR; PG8_SCHED;
            PG8_STAGE(PG8_SB(1, 1), b3 + hstepB, voffB);
            PG8_WAIT_V(6); PG8_BAR; PG8_MMA(1, 1, At, B1); PG8_BAR;
            }
        }
        if constexpr (ALIGN_EPI) { if (wr == 0) PG8_BAR; }
        if constexpr (!Epi::AFTER_DRAIN) { E(acc, cur, wr, wc, fr, fq); S.done(cur); }
        if (!has_next) break;
#pragma unroll
        for (int a = 0; a < 2; ++a)
#pragma unroll
            for (int b = 0; b < 2; ++b)
#pragma unroll
                for (int m = 0; m < 4; ++m)
#pragma unroll
                    for (int n = 0; n < 2; ++n) acc[a][b][m][n] = (f32x4){0.f, 0.f, 0.f, 0.f};
        cur = nxt; cA = nA; cB = nB; ++ui;
        if constexpr (ALIGN_EPI) { if (wr == 1) PG8_BAR; }
    }
    PG8_WAIT_V(0);
    if constexpr (!ALIGN_EPI) { if (wr == 0) PG8_BAR; }
    PG8_BAR;
    if constexpr (Epi::AFTER_DRAIN) { E.fused(acc, cur, wr, wc, fr, fq, lds, wid, lane); S.done(cur); }
#undef PG8_SA
#undef PG8_SB
#undef PG8_STAGE
#undef PG8_LDA
#undef PG8_LDB
#undef PG8_MMA
#undef PG8_WAIT_V
#undef PG8_WAIT_L
#undef PG8_BAR
#undef PG8_SCHED
}
}

namespace mk {
using pg8::bf16_t; using pg8::f32x4; using pg8::u32x4; using pg8::bf16x8; using pg8::Unit;
#define LAS __attribute__((address_space(3)))
typedef float f32x16 __attribute__((ext_vector_type(16)));
typedef short s16x4 __attribute__((ext_vector_type(4)));
typedef unsigned u32x2 __attribute__((ext_vector_type(2)));
typedef __bf16 bf16x2_t __attribute__((ext_vector_type(2)));
typedef float f32x2_t __attribute__((ext_vector_type(2)));

constexpr int D = 2048, BATCH = 4, SEQ = 4096, M = BATCH * SEQ, DFF = 5504, NGU = 2 * DFF, INW = 6656, PW = 1024, AW = 1024, KVW = 256, NMOD = 9 * D;
constexpr float ALPHA = 1.189207115002721f;
constexpr float LN_EPS = 1e-5f, LOG2E = 1.4426950408889634f;
constexpr int NWAVES = 8, NTHREADS = 512;
constexpr int LDS_BYTES = 147456;

constexpr size_t MiB = 1u << 20;
constexpr size_t WS_MOD = 0;
constexpr size_t WS_BAR = 384 * 1024, WS_BAR_BYTES = 16384;
constexpr size_t WS_ROPE = 512 * 1024;
constexpr size_t WS_WGU1 = 2 * MiB;
constexpr size_t WS_WD1 = WS_WGU1 + 43 * MiB;
constexpr size_t WS_WGU2 = WS_WD1 + 22 * MiB;
constexpr size_t WS_WD2 = WS_WGU2 + 43 * MiB;
constexpr size_t WS_WIN = WS_WD2 + 22 * MiB;
constexpr size_t WS_WP = WS_WIN + 26 * MiB;
constexpr size_t WS_WA = WS_WP + 1 * MiB;
constexpr size_t WS_WB = WS_WA + 4 * MiB;
constexpr size_t WS_WO = WS_WB + 4 * MiB;
constexpr size_t WS_U = WS_WO + 8 * MiB;
constexpr size_t WS_BIG = WS_U + 64 * MiB;
constexpr size_t WS_XP = WS_BIG, WS_Q = WS_XP + 32 * MiB, WS_K = WS_Q + 32 * MiB, WS_V = WS_K + 8 * MiB, WS_POOLED = WS_V + 8 * MiB, WS_MIXED = WS_POOLED + 32 * MiB, WS_O = WS_MIXED + 32 * MiB;
constexpr size_t WS_SGA = WS_BIG + 176 * MiB;
constexpr size_t WS_SGB = WS_SGA + 64 * MiB;
constexpr size_t WS_END = WS_SGB + 64 * MiB;
static_assert(WS_O + 32 * MiB <= WS_SGA && (size_t)M * DFF * 2 <= 176 * MiB && (size_t)D * DFF * 2 <= 22 * MiB, "ws map");

__device__ __forceinline__ unsigned pk_bf16(float lo, float hi) { f32x2_t v = {lo, hi}; bf16x2_t b = __builtin_convertvector(v, bf16x2_t); return __builtin_bit_cast(unsigned, b); }
__device__ __forceinline__ float bf_lo(unsigned w) { return __builtin_bit_cast(float, w << 16); }
__device__ __forceinline__ float bf_hi(unsigned w) { return __builtin_bit_cast(float, w & 0xffff0000u); }
__device__ __forceinline__ float sigmoid_f(float a) { return __builtin_amdgcn_rcpf(1.0f + __builtin_amdgcn_exp2f(-LOG2E * a)); }
__device__ __forceinline__ float silu_f(float a) { return a * sigmoid_f(a); }
__device__ __forceinline__ u32x4 pk8(const f32x4 v0, const f32x4 v1) { u32x4 w; w.x = pk_bf16(v0[0], v0[1]); w.y = pk_bf16(v0[2], v0[3]); w.z = pk_bf16(v1[0], v1[1]); w.w = pk_bf16(v1[2], v1[3]); return w; }

struct EpiSwiglu {
    static constexpr bool PERM = true, AFTER_DRAIN = false;
    bf16_t* H;
    __device__ __forceinline__ void operator()(const f32x4 (&acc)[2][2][4][2], const Unit& u, int wr, int wc, int fr, int fq) const {
        const int row0 = u.pm * 256 + wr * 64 + fr, col0 = u.pn * 128 + wc * 32 + 8 * fq;
#pragma unroll
        for (int ai = 0; ai < 2; ++ai)
#pragma unroll
            for (int m = 0; m < 4; ++m) { bf16_t* rowp = H + (size_t)(row0 + ai * 128 + m * 16) * DFF + col0;
                f32x4 h0, h1;
#pragma unroll
                for (int e = 0; e < 4; ++e) { h0[e] = silu_f(acc[ai][0][m][0][e]) * acc[ai][1][m][0][e]; h1[e] = silu_f(acc[ai][0][m][1][e]) * acc[ai][1][m][1][e]; }
                *(u32x4*)rowp = pk8(h0, h1); }
    }
};
struct EpiResid {
    static constexpr bool PERM = false, AFTER_DRAIN = false;
    const float* xin; float* zout; const float* gate; float w;
    __device__ __forceinline__ void operator()(const f32x4 (&acc)[2][2][4][2], const Unit& u, int wr, int wc, int fr, int fq) const {
        const int row0 = u.pm * 256 + wr * 64 + fr, col0 = u.pn * 256 + wc * 32 + 4 * fq;
        const float* gp = gate + (size_t)(u.pm >> 4) * NMOD + col0;
        f32x4 gv[2][2];
#pragma unroll
        for (int bj = 0; bj < 2; ++bj)
#pragma unroll
            for (int n = 0; n < 2; ++n) gv[bj][n] = (*(const f32x4*)(gp + bj * 128 + n * 16) + 1.0f) * w;
#pragma unroll
        for (int ai = 0; ai < 2; ++ai)
#pragma unroll
            for (int m = 0; m < 4; ++m) { const size_t off = (size_t)(row0 + ai * 128 + m * 16) * D + col0;
#pragma unroll
                for (int bj = 0; bj < 2; ++bj)
#pragma unroll
                    for (int n = 0; n < 2; ++n) { const f32x4 xv = *(const f32x4*)(xin + off + bj * 128 + n * 16);
                        *(f32x4*)(zout + off + bj * 128 + n * 16) = xv * ALPHA + gv[bj][n] * acc[ai][bj][m][n]; }
                asm volatile("" ::: "memory"); }
    }
};
struct EpiInProj {
    static constexpr bool PERM = true, AFTER_DRAIN = false;
    const float* bias; const float* rope; bf16_t *XP, *Q, *Kb, *Vb, *SGA, *SGB;
    __device__ __forceinline__ void operator()(const f32x4 (&acc)[2][2][4][2], const Unit& u, int wr, int wc, int fr, int fq) const {
        const int pn = u.pn; bf16_t* base; int ld, colt, mode; float sc = 1.f;
        if (pn < 4) { base = XP; ld = PW; colt = pn * 256; mode = 0; }
        else if (pn < 8) { base = Q; ld = AW; colt = (pn - 4) * 256; mode = 1; sc = 0.125f; }
        else if (pn == 8) { base = Kb; ld = KVW; colt = 0; mode = 1; }
        else if (pn == 9) { base = Vb; ld = KVW; colt = 0; mode = 0; }
        else if (pn < 18) { base = SGA; ld = D; colt = (pn - 10) * 256; mode = 2; }
        else { base = SGB; ld = D; colt = (pn - 18) * 256; mode = 2; }
        const int row0 = u.pm * 256 + wr * 64 + fr, col0 = colt + wc * 32 + 8 * fq, bcol0 = pn * 256 + wc * 32 + 8 * fq;
        f32x4 bv[2][2];
#pragma unroll
        for (int bj = 0; bj < 2; ++bj)
#pragma unroll
            for (int n = 0; n < 2; ++n) bv[bj][n] = *(const f32x4*)(bias + bcol0 + bj * 128 + 4 * n);
        const bool dorope = (mode == 1) && ((wc & 1) == 0);
        const float sg = (fq == 0) ? -1.f : 1.f;
#pragma unroll
        for (int ai = 0; ai < 2; ++ai)
#pragma unroll
            for (int m = 0; m < 4; ++m) { const int row = row0 + ai * 128 + m * 16;
                f32x4 c0 = {1.f, 1.f, 1.f, 1.f}, c1 = c0, s0 = {0.f, 0.f, 0.f, 0.f}, s1 = s0;
                if (dorope && fq < 2) { const float* rp = rope + (size_t)(row & (SEQ - 1)) * 16; c0 = *(const f32x4*)rp; c1 = *(const f32x4*)(rp + 4); s0 = *(const f32x4*)(rp + 8) * sg; s1 = *(const f32x4*)(rp + 12) * sg; }
#pragma unroll
                for (int bj = 0; bj < 2; ++bj) { f32x4 v0 = acc[ai][bj][m][0] + bv[bj][0], v1 = acc[ai][bj][m][1] + bv[bj][1];
                    if (dorope) { f32x4 p0, p1;
#pragma unroll
                        for (int e = 0; e < 4; ++e) { p0[e] = __shfl_xor(v0[e], 16); p1[e] = __shfl_xor(v1[e], 16); }
                        v0 = v0 * c0 + p0 * s0; v1 = v1 * c1 + p1 * s1; }
                    if (mode == 2) {
#pragma unroll
                        for (int e = 0; e < 4; ++e) { v0[e] = sigmoid_f(v0[e]); v1[e] = sigmoid_f(v1[e]); } }
                    v0 = v0 * sc; v1 = v1 * sc;
                    *(u32x4*)(base + (size_t)row * ld + col0 + bj * 128) = pk8(v0, v1); } }
    }
};
struct EpiPool {
    static constexpr bool PERM = true, AFTER_DRAIN = false;
    bf16_t* O; const float* scale;
    __device__ __forceinline__ void operator()(const f32x4 (&acc)[2][2][4][2], const Unit& u, int wr, int wc, int fr, int fq) const {
        const int row0 = u.pm * 256 + wr * 64 + fr, col0 = u.pn * 256 + wc * 32 + 8 * fq;
        f32x4 sv[2][2];
#pragma unroll
        for (int bj = 0; bj < 2; ++bj)
#pragma unroll
            for (int n = 0; n < 2; ++n) sv[bj][n] = *(const f32x4*)(scale + col0 + bj * 128 + 4 * n);
#pragma unroll
        for (int ai = 0; ai < 2; ++ai)
#pragma unroll
            for (int m = 0; m < 4; ++m) { bf16_t* rowp = O + (size_t)(row0 + ai * 128 + m * 16) * PW + col0;
#pragma unroll
                for (int bj = 0; bj < 2; ++bj) *(u32x4*)(rowp + bj * 128) = pk8(acc[ai][bj][m][0] * sv[bj][0], acc[ai][bj][m][1] * sv[bj][1]); }
    }
};
template <int MODE> struct EpiGate {
    static constexpr bool PERM = true, AFTER_DRAIN = false;
    bf16_t* G; const bf16_t* YA; bf16_t* OUT;
    __device__ __forceinline__ void operator()(const f32x4 (&acc)[2][2][4][2], const Unit& u, int wr, int wc, int fr, int fq) const {
        const int row0 = u.pm * 256 + wr * 64 + fr, col0 = u.pn * 256 + wc * 32 + 8 * fq;
#pragma unroll
        for (int ai = 0; ai < 2; ++ai)
#pragma unroll
            for (int m = 0; m < 4; ++m) { const size_t off = (size_t)(row0 + ai * 128 + m * 16) * D + col0;
#pragma unroll
                for (int bj = 0; bj < 2; ++bj) { const u32x4 gw = *(const u32x4*)(G + off + bj * 128);
                    f32x4 v0 = {bf_lo(gw.x), bf_hi(gw.x), bf_lo(gw.y), bf_hi(gw.y)}, v1 = {bf_lo(gw.z), bf_hi(gw.z), bf_lo(gw.w), bf_hi(gw.w)};
                    v0 = v0 * acc[ai][bj][m][0]; v1 = v1 * acc[ai][bj][m][1];
                    if (MODE == 1) { const u32x4 yw = *(const u32x4*)(YA + off + bj * 128);
                        v0 += (f32x4){bf_lo(yw.x), bf_hi(yw.x), bf_lo(yw.y), bf_hi(yw.y)}; v1 += (f32x4){bf_lo(yw.z), bf_hi(yw.z), bf_lo(yw.w), bf_hi(yw.w)};
                        *(u32x4*)(OUT + off + bj * 128) = pk8(v0, v1); }
                    else *(u32x4*)(G + off + bj * 128) = pk8(v0, v1); }
                asm volatile("" ::: "memory"); }
    }
};

#define MFMA32(a, b, c) __builtin_amdgcn_mfma_f32_32x32x16_bf16((a), (b), (c), 0, 0, 0)
constexpr int KS_PITCH = 144, VT_PITCH = 260  , ATT_VT_OFF = 256 * KS_PITCH;
__device__ __forceinline__ void attn_phase(LAS unsigned char* lds, const bf16_t* Q, const bf16_t* Kb, const bf16_t* Vb, bf16_t* O, const float* sinks, int G, int bid) {
    const int tid = threadIdx.x, lane = tid & 63, wid = __builtin_amdgcn_readfirstlane(tid >> 6), r = lane & 31, h = lane >> 5;
    LAS unsigned char* Ks = lds;
    LAS bf16_t* Vt = (LAS bf16_t*)(lds + ATT_VT_OFF);
    const int rg = wid & 3, hp = wid >> 2;
    for (int item = bid; item < BATCH * 4 * 32; item += G) {
        const int qblk = item & 31, kvh = (item >> 5) & 3, b = item >> 7;
        const long tokbase = (long)b * SEQ + qblk * 128 - 128;
#pragma unroll
        for (int i = 0; i < 4; ++i) { const int cid = tid + 512 * i;
            { const int key = cid >> 3, part = cid & 7; u32x4 v = {0u, 0u, 0u, 0u};
              if (qblk > 0 || key >= 128) v = *(const u32x4*)(Kb + (size_t)(tokbase + key) * KVW + kvh * 64 + part * 8);
              *(LAS u32x4*)(Ks + key * KS_PITCH + part * 16) = v; }
            { const int key = cid & 255, part = cid >> 8; u32x4 v = {0u, 0u, 0u, 0u};
              if (qblk > 0 || key >= 128) v = *(const u32x4*)(Vb + (size_t)(tokbase + key) * KVW + kvh * 64 + part * 8);
              LAS bf16_t* vp = Vt + (part * 8) * VT_PITCH + key;
              vp[0 * VT_PITCH] = (bf16_t)(v.x & 0xffffu); vp[1 * VT_PITCH] = (bf16_t)(v.x >> 16); vp[2 * VT_PITCH] = (bf16_t)(v.y & 0xffffu); vp[3 * VT_PITCH] = (bf16_t)(v.y >> 16);
              vp[4 * VT_PITCH] = (bf16_t)(v.z & 0xffffu); vp[5 * VT_PITCH] = (bf16_t)(v.z >> 16); vp[6 * VT_PITCH] = (bf16_t)(v.w & 0xffffu); vp[7 * VT_PITCH] = (bf16_t)(v.w >> 16); }
        }
        __syncthreads();
#pragma unroll 1
        for (int hh = 0; hh < 2; ++hh) {
            const int qh = kvh * 4 + hp * 2 + hh;
            const size_t tok = (size_t)b * SEQ + qblk * 128 + 32 * rg + r;
            const float sink = sinks[qh];
            bf16x8 qf[4];
#pragma unroll
            for (int s = 0; s < 4; ++s) qf[s] = *(const bf16x8*)(Q + tok * AW + qh * 64 + 16 * s + 8 * h);
            f32x16 S[5];
            float mx = -1e30f;
#pragma unroll
            for (int t = 0; t < 5; ++t) {
                f32x16 a;
#pragma unroll
                for (int i = 0; i < 16; ++i) a[i] = 0.f;
                const LAS unsigned char* kp = Ks + (32 * (rg + t) + r) * KS_PITCH + 16 * h;
#pragma unroll
                for (int s = 0; s < 4; ++s) a = MFMA32(*(const LAS bf16x8*)(kp + 32 * s), qf[s], a);
                const bool dead = (qblk == 0) && (rg + t < 4);
#pragma unroll
                for (int i = 0; i < 16; ++i) { const int cr = (i & 3) + 8 * (i >> 2) + 4 * h;
                    bool valid = !dead; if (t == 0) valid = valid && (cr > r); if (t == 4) valid = valid && (cr <= r);
                    const float sv = valid ? a[i] : -1e30f; a[i] = sv; mx = fmaxf(mx, sv); }
                S[t] = a; __builtin_amdgcn_sched_barrier(0);
            }
            mx = fmaxf(mx, __shfl_xor(mx, 32)); mx = fmaxf(mx, sink);
            float sum = 0.f; const float mxl = mx * LOG2E;
#pragma unroll
            for (int t = 0; t < 5; ++t)
#pragma unroll
                for (int i = 0; i < 16; ++i) { const float p = __builtin_amdgcn_exp2f(S[t][i] * LOG2E - mxl); S[t][i] = p; sum += p; }
            sum += __shfl_xor(sum, 32); sum += __builtin_amdgcn_exp2f(sink * LOG2E - mxl);
            const float inv = 1.0f / sum;
            f32x16 o0, o1;
#pragma unroll
            for (int i = 0; i < 16; ++i) { o0[i] = 0.f; o1[i] = 0.f; }
#pragma unroll
            for (int t = 0; t < 5; ++t)
#pragma unroll
                for (int s2 = 0; s2 < 2; ++s2) {
                    u32x4 pw; pw.x = pk_bf16(S[t][8 * s2 + 0], S[t][8 * s2 + 1]); pw.y = pk_bf16(S[t][8 * s2 + 2], S[t][8 * s2 + 3]); pw.z = pk_bf16(S[t][8 * s2 + 4], S[t][8 * s2 + 5]); pw.w = pk_bf16(S[t][8 * s2 + 6], S[t][8 * s2 + 7]);
                    const bf16x8 pf = __builtin_bit_cast(bf16x8, pw);
                    const LAS bf16_t* vp = Vt + r * VT_PITCH + 32 * (rg + t) + 16 * s2 + 4 * h;
                    const s16x4 a0 = *(const LAS s16x4*)vp, a1 = *(const LAS s16x4*)(vp + 8), b0 = *(const LAS s16x4*)(vp + 32 * VT_PITCH), b1 = *(const LAS s16x4*)(vp + 32 * VT_PITCH + 8);
                    o0 = MFMA32(__builtin_shufflevector(a0, a1, 0, 1, 2, 3, 4, 5, 6, 7), pf, o0);
                    o1 = MFMA32(__builtin_shufflevector(b0, b1, 0, 1, 2, 3, 4, 5, 6, 7), pf, o1);
                    __builtin_amdgcn_sched_barrier(0);
                }
            bf16_t* op = O + tok * AW + qh * 64 + 4 * h;
#pragma unroll
            for (int g = 0; g < 4; ++g) {
                u32x2 w0, w1; w0.x = pk_bf16(o0[4 * g] * inv, o0[4 * g + 1] * inv); w0.y = pk_bf16(o0[4 * g + 2] * inv, o0[4 * g + 3] * inv);
                w1.x = pk_bf16(o1[4 * g] * inv, o1[4 * g + 1] * inv); w1.y = pk_bf16(o1[4 * g + 2] * inv, o1[4 * g + 3] * inv);
                *(u32x2*)(op + 8 * g) = w0; *(u32x2*)(op + 32 + 8 * g) = w1; }
        }
        __syncthreads();
    }
}

__device__ __forceinline__ void pool_phase(const bf16_t* XP, bf16_t* P, int gw, int NGW, int lane) {
    for (int it = gw; it < 2 * M; it += NGW) {
        const int row = it >> 1, c0 = (it & 1) * 512 + lane * 8, g = c0 >> 8, w = 2 << g, pos = row & (SEQ - 1);
        const int cnt = (pos + 1 < w) ? pos + 1 : w;
        const bf16_t* src = XP + (size_t)row * PW + c0;
        float a[8];
#pragma unroll
        for (int e = 0; e < 8; ++e) a[e] = 0.f;
        const u32x4 x0 = *(const u32x4*)src;
        for (int j = 1; j < cnt; ++j) { const u32x4 v = *(const u32x4*)(src - (size_t)j * PW);
            a[0] += bf_lo(v.x); a[1] += bf_hi(v.x); a[2] += bf_lo(v.y); a[3] += bf_hi(v.y); a[4] += bf_lo(v.z); a[5] += bf_hi(v.z); a[6] += bf_lo(v.w); a[7] += bf_hi(v.w); }
        const float xs[8] = {bf_lo(x0.x), bf_hi(x0.x), bf_lo(x0.y), bf_hi(x0.y), bf_lo(x0.z), bf_hi(x0.z), bf_lo(x0.w), bf_hi(x0.w)};
        const float ic = 1.0f / (float)cnt; float o[8];
#pragma unroll
        for (int e = 0; e < 8; ++e) o[e] = (a[e] + xs[e]) * ic - xs[e];
        u32x4 ow; ow.x = pk_bf16(o[0], o[1]); ow.y = pk_bf16(o[2], o[3]); ow.z = pk_bf16(o[4], o[5]); ow.w = pk_bf16(o[6], o[7]);
        *(u32x4*)(P + (size_t)row * PW + c0) = ow;
    }
}

__device__ __forceinline__ float wave_sum(float v) {
#pragma unroll
    for (int o = 1; o < 64; o <<= 1) v += __shfl_xor(v, o);
    return v;
}
template <int MODE> __device__ __forceinline__ void row_phase(const float* xin, float* xout, bf16_t* U, const float* lng, const float* lnb, const float* shift, const float* scale, int gw, int NGW, int lane) {
    for (int row = gw; row < M; row += NGW) {
        const f32x4* xr = (const f32x4*)(xin + (size_t)row * D) + lane;
        f32x4 v[8];
#pragma unroll
        for (int j = 0; j < 8; ++j) v[j] = xr[64 * j];
        if (MODE != 0) {
            float s = 0.f;
#pragma unroll
            for (int j = 0; j < 8; ++j) s += (v[j][0] + v[j][1]) + (v[j][2] + v[j][3]);
            const float mean = wave_sum(s) * (1.0f / D); float s2 = 0.f;
#pragma unroll
            for (int j = 0; j < 8; ++j) { v[j] = v[j] - mean; s2 += (v[j][0] * v[j][0] + v[j][1] * v[j][1]) + (v[j][2] * v[j][2] + v[j][3] * v[j][3]); }
            const float rstd = 1.0f / sqrtf(wave_sum(s2) * (1.0f / D) + LN_EPS);
            f32x4* xo = (f32x4*)(xout + (size_t)row * D) + lane;
#pragma unroll
            for (int j = 0; j < 8; ++j) { const f32x4 gg = *((const f32x4*)lng + lane + 64 * j), bb = *((const f32x4*)lnb + lane + 64 * j); v[j] = v[j] * rstd * gg + bb; xo[64 * j] = v[j]; }
        }
        if (MODE != 2) {
            const int b = row >> 12;
            const f32x4* sh = (const f32x4*)(shift + (size_t)b * NMOD) + lane; const f32x4* sc = (const f32x4*)(scale + (size_t)b * NMOD) + lane;
            u32x2* uo = (u32x2*)(U + (size_t)row * D) + lane;
#pragma unroll
            for (int j = 0; j < 8; ++j) { const f32x4 t = v[j] * (sc[64 * j] + 1.0f) + sh[64 * j]; u32x2 w; w.x = pk_bf16(t[0], t[1]); w.y = pk_bf16(t[2], t[3]); uo[64 * j] = w; }
        }
    }
}

__device__ __forceinline__ void transpose_item(const float* W, int K, int N, bf16_t* WT, int k0, int n0, int drow0, LAS float* scr, int lane) {
#pragma unroll 8
    for (int i = 0; i < 32; ++i) { const int kk = 2 * i + (lane >> 5); scr[kk * 33 + (lane & 31)] = W[(size_t)(k0 + kk) * N + n0 + (lane & 31)]; }
    asm volatile("s_waitcnt lgkmcnt(0)" ::: "memory");
    const int c = lane & 7;
#pragma unroll
    for (int j = 0; j < 4; ++j) { const int n = (lane >> 3) + 8 * j; const LAS float* s = scr + (8 * c) * 33 + n;
        u32x4 o; o.x = pk_bf16(s[0 * 33], s[1 * 33]); o.y = pk_bf16(s[2 * 33], s[3 * 33]); o.z = pk_bf16(s[4 * 33], s[5 * 33]); o.w = pk_bf16(s[6 * 33], s[7 * 33]);
        *(u32x4*)(WT + (size_t)(drow0 + n) * K + k0 + 8 * c) = o; }
    asm volatile("s_waitcnt lgkmcnt(0)" ::: "memory");
}
__device__ __forceinline__ void transpose_plain(const float* W, int K, int N, bf16_t* WT, int item, LAS float* scr, int lane) {
    const int nblk = N / 32, kb = item / nblk, nb = item % nblk; transpose_item(W, K, N, WT, 64 * kb, 32 * nb, 32 * nb, scr, lane);
}
__device__ __forceinline__ void transpose_gu(const float* W, bf16_t* WT, int item, LAS float* scr, int lane) {
    const int nblk = NGU / 32, kb = item / nblk, nb = item % nblk, n0 = 32 * nb, bj = n0 / DFF, rem = n0 - bj * DFF, pn = rem >> 7, i0 = rem & 127;
    transpose_item(W, D, NGU, WT, 64 * kb, n0, 256 * pn + 128 * bj + i0, scr, lane);
}

#define RLX_AGENT __ATOMIC_RELAXED, __HIP_MEMORY_SCOPE_AGENT
#define XB_TMO      128
#define XB_XCNT(j)  (256  + 64 * (j))
#define XB_XSUB(j)  (1280 + 64 * (j))
#define XB_XGEN(j)  (2304 + 64 * (j))
#define XB_TOP      3328
#define XB_TOPGEN   3392
#define XCD_BAR_WORDS 3456
#define XB_SPIN_CAP (1u << 18)

__device__ __forceinline__ unsigned xb_ld(unsigned* p)              { return __hip_atomic_load(p, __ATOMIC_RELAXED, __HIP_MEMORY_SCOPE_AGENT); }
__device__ __forceinline__ unsigned xb_add(unsigned* p, unsigned v) { return __hip_atomic_fetch_add(p, v, __ATOMIC_RELAXED, __HIP_MEMORY_SCOPE_AGENT); }
__device__ __forceinline__ unsigned xb_xcc_id() { return (unsigned)__builtin_amdgcn_s_getreg((3 << 11) | 20) & 0xFu; }
#define XB_SPIN(cond, bar) do { unsigned _sp = 0; while (cond) { __builtin_amdgcn_s_sleep(1); \
    if ((++_sp & 255u) == 0u) { if (xb_ld(&(bar)[XB_TMO])) break; if (_sp > XB_SPIN_CAP) { atomicAdd(&(bar)[XB_TMO], 1u); break; } } } } while (0)

struct XcdBarrier {
    unsigned* bar; unsigned x;
    volatile LAS unsigned* st;
};

__device__ __forceinline__ XcdBarrier xcd_barrier_post(unsigned* bar, volatile LAS unsigned* st) {
    XcdBarrier b; b.bar = bar; b.x = xb_xcc_id(); b.st = st;
    if (threadIdx.x == 0) (void)xb_add(&bar[XB_XCNT(b.x)], 1u);
    return b;
}
__device__ __forceinline__ void xcd_barrier_complete(unsigned* bar, unsigned x, unsigned& nloc, unsigned& nx) {
    const unsigned G = gridDim.x * gridDim.y * gridDim.z;
    unsigned sum, cnt, mine, sp = 0u;
    for (;;) {
        sum = 0u; cnt = 0u; mine = 0u;
#pragma unroll
        for (unsigned j = 0; j < 16; ++j) { const unsigned c = xb_ld(&bar[XB_XCNT(j)]); sum += c; cnt += (c > 0u) ? 1u : 0u; mine = (j == x) ? c : mine; }
        if (sum == G) break;
        __builtin_amdgcn_s_sleep(1);
        if ((++sp & 255u) == 0u) { if (xb_ld(&bar[XB_TMO])) break; if (sp > XB_SPIN_CAP) { atomicAdd(&bar[XB_TMO], 1u); break; } }
    }
    nloc = mine > 0u ? mine : 1u; nx = cnt > 0u ? cnt : 1u;
}

__device__ __forceinline__ void xcd_barrier(const XcdBarrier& b) {
    asm volatile("s_waitcnt vmcnt(0)" ::: "memory");
    __syncthreads();
    if (threadIdx.x == 0) {
        unsigned* bar = b.bar;
        __builtin_amdgcn_s_waitcnt(0);
        unsigned nloc = b.st[0], nx = b.st[1];
        if (nloc == 0u) { xcd_barrier_complete(bar, b.x, nloc, nx); b.st[0] = nloc; b.st[1] = nx; }
        const unsigned old = xb_add(&bar[XB_XSUB(b.x)], 1u);
        const unsigned gen = old / nloc;
        if (old + 1u == (gen + 1u) * nloc) {
            __builtin_amdgcn_fence(__ATOMIC_RELEASE, "agent");
            asm volatile("s_waitcnt vmcnt(0)" ::: "memory");
            const unsigned og = xb_add(&bar[XB_TOP], 1u);
            const unsigned tg = og / nx;
            if (og + 1u == (tg + 1u) * nx) xb_add(&bar[XB_TOPGEN], 1u);
            else XB_SPIN(xb_ld(&bar[XB_TOPGEN]) == tg, bar);
            __builtin_amdgcn_fence(__ATOMIC_ACQUIRE, "agent");
            xb_add(&bar[XB_XGEN(b.x)], 1u);
            asm volatile("s_waitcnt vmcnt(0)" ::: "memory");
        } else {
            XB_SPIN(xb_ld(&bar[XB_XGEN(b.x)]) == gen, bar);
            __builtin_amdgcn_fence(__ATOMIC_ACQUIRE, "agent");
            asm volatile("s_waitcnt vmcnt(0)" ::: "memory");
        }
    }
    __syncthreads();
}

struct Args { const float* in[18]; float* out; unsigned char* ws; float inv_freq[8]; int ph_lo, ph_hi; };
constexpr int N_PHASES = 14;

__global__ void __launch_bounds__(NTHREADS, 2) fwd_kernel(Args args) {
    extern __shared__ __attribute__((aligned(16))) unsigned char lds_raw[];
    LAS unsigned char* lds = (LAS unsigned char*)lds_raw;
    const int tid = threadIdx.x, lane = tid & 63, wave = __builtin_amdgcn_readfirstlane(tid >> 6);
    const int G = gridDim.x, bid = blockIdx.x;
    const int gw = bid * NWAVES + wave, NGW = G * NWAVES;
#define x (args.in[0])
#define c (args.in[1])
#define w_ada (args.in[2])
#define b_ada (args.in[3])
#define ln_g (args.in[4])
#define ln_b (args.in[5])
#define w_ffn1_in (args.in[6])
#define w_ffn1_out (args.in[7])
#define w_in (args.in[8])
#define b_in (args.in[9])
#define w_pool (args.in[10])
#define pool_scale (args.in[11])
#define sinks (args.in[12])
#define w_branch_a (args.in[13])
#define w_branch_b (args.in[14])
#define w_out (args.in[15])
#define w_ffn2_in (args.in[16])
#define w_ffn2_out (args.in[17])
#define out (args.out)
#define WSP(T, off) ((T*)(args.ws + (off)))
#define MOD WSP(float, WS_MOD)
#define ROPE WSP(float, WS_ROPE)
#define WGU1 WSP(bf16_t, WS_WGU1)
#define WD1 WSP(bf16_t, WS_WD1)
#define WGU2 WSP(bf16_t, WS_WGU2)
#define WD2 WSP(bf16_t, WS_WD2)
#define WIN WSP(bf16_t, WS_WIN)
#define WP WSP(bf16_t, WS_WP)
#define WA WSP(bf16_t, WS_WA)
#define WB WSP(bf16_t, WS_WB)
#define WO WSP(bf16_t, WS_WO)
#define U WSP(bf16_t, WS_U)
#define MERGED WSP(bf16_t, WS_U)
#define H WSP(bf16_t, WS_BIG)
#define XP WSP(bf16_t, WS_XP)
#define Q WSP(bf16_t, WS_Q)
#define KB WSP(bf16_t, WS_K)
#define VB WSP(bf16_t, WS_V)
#define POOLED WSP(bf16_t, WS_POOLED)
#define MIXED WSP(bf16_t, WS_MIXED)
#define OB WSP(bf16_t, WS_O)
#define SGA WSP(bf16_t, WS_SGA)
#define SGB WSP(bf16_t, WS_SGB)
    const int lo = args.ph_lo, hi = args.ph_hi;
#if MK_ONE_LAUNCH
    volatile LAS unsigned* MISC = (volatile LAS unsigned*)(lds + 131072 + 320);
    if (tid < 32) MISC[tid] = 0u;
    __syncthreads();
    XcdBarrier bar = xcd_barrier_post((unsigned*)(args.ws + WS_BAR), MISC + 8);
    if (hi > 1000) cg::this_grid().sync();
#endif
#ifndef MK_PHASES
#define MK_PHASES 0x3fff
#endif
#define IN(k) (((MK_PHASES >> (k)) & 1) && lo <= (k) && (k) < hi)
#if MK_ONE_LAUNCH
#define SEAM(k) do { if (IN(k) && IN((k) + 1)) xcd_barrier(bar); } while (0)
#else
#define SEAM(k) do { } while (0)
#endif
#define GEMM(EPI, g, S, E) pg8::gemm_phase<EPI, pg8::StaticOrder, true, true>(lds, g, S, E)

    if (IN(0)) {
        LAS float* cact = (LAS float*)lds;
        LAS float* red = (LAS float*)(lds + 32768);
        for (int i = tid; i < BATCH * D; i += NTHREADS) cact[i] = silu_f(c[i]);
        __syncthreads();
        for (int item = bid; item < 256; item += G) {
            const int col0 = item * 72, rsub = lane / 18, cl = lane - rsub * 18;
            f32x4 a0 = {0.f, 0.f, 0.f, 0.f}, a1 = a0, a2 = a0, a3 = a0;
            if (lane < 54) {
                const float* wp = w_ada + col0 + 4 * cl;
#pragma unroll 8
                for (int k = wave * 256 + rsub; k < wave * 256 + 256; k += 3) { const f32x4 wv = *(const f32x4*)(wp + (size_t)k * NMOD);
                    a0 += wv * cact[k]; a1 += wv * cact[D + k]; a2 += wv * cact[2 * D + k]; a3 += wv * cact[3 * D + k]; }
                LAS float* rp = red + ((wave * 3 + rsub) * 4) * 72 + 4 * cl;
                *(LAS f32x4*)(rp) = a0; *(LAS f32x4*)(rp + 72) = a1; *(LAS f32x4*)(rp + 144) = a2; *(LAS f32x4*)(rp + 216) = a3;
            }
            __syncthreads();
            if (tid < 288) { const int b = tid / 72, cc = tid - b * 72; float s = b_ada[col0 + cc];
                for (int p = 0; p < 24; ++p) s += red[(p * 4 + b) * 72 + cc];
                MOD[(size_t)b * NMOD + col0 + cc] = s; }
            __syncthreads();
        }
        for (int i = bid * NTHREADS + tid; i < SEQ * 8; i += G * NTHREADS) { const int pos = i >> 3, j = i & 7; const float ang = (float)pos * args.inv_freq[j];
            ROPE[pos * 16 + j] = cosf(ang); ROPE[pos * 16 + 8 + j] = sinf(ang); }
        __syncthreads();
        LAS float* scr = (LAS float*)(lds + wave * 16384);
        constexpr int I_GU = (D / 64) * (NGU / 32), I_DN = (DFF / 64) * (D / 32), I_IN = (D / 64) * (INW / 32), I_P = 4 * 8, I_BR = (1024 / 64) * (D / 32), I_O = (D / 64) * (D / 32);
        constexpr int NITEMS = 2 * I_GU + 2 * I_DN + I_IN + 4 * I_P + 2 * I_BR + I_O;
        for (int it = gw; it < NITEMS; it += NGW) {
            int r = it;
            if (r < I_GU) { transpose_gu(w_ffn1_in, WGU1, r, scr, lane); continue; } r -= I_GU;
            if (r < I_DN) { transpose_plain(w_ffn1_out, DFF, D, WD1, r, scr, lane); continue; } r -= I_DN;
            if (r < I_IN) { transpose_plain(w_in, D, INW, WIN, r, scr, lane); continue; } r -= I_IN;
            if (r < 4 * I_P) { const int g = r / I_P; transpose_plain(w_pool + (size_t)g * 65536, 256, 256, WP + (size_t)g * 65536, r - g * I_P, scr, lane); continue; } r -= 4 * I_P;
            if (r < I_BR) { transpose_plain(w_branch_a, 1024, D, WA, r, scr, lane); continue; } r -= I_BR;
            if (r < I_BR) { transpose_plain(w_branch_b, 1024, D, WB, r, scr, lane); continue; } r -= I_BR;
            if (r < I_O) { transpose_plain(w_out, D, D, WO, r, scr, lane); continue; } r -= I_O;
            if (r < I_GU) { transpose_gu(w_ffn2_in, WGU2, r, scr, lane); continue; } r -= I_GU;
            transpose_plain(w_ffn2_out, DFF, D, WD2, r, scr, lane);
        }
        __syncthreads();
    }
    SEAM(0);
    if (IN(1)) row_phase<0>(x, nullptr, U, nullptr, nullptr, MOD + 0 * D, MOD + 1 * D, gw, NGW, lane);
    SEAM(1);
    if (IN(2)) { pg8::Gemm g{U, WGU1, D, D, D, 0}; pg8::StaticOrder S; S.init(M, NGU, G, bid); EpiSwiglu E{H}; GEMM(EpiSwiglu, g, S, E); }
    SEAM(2);
    if (IN(3)) { pg8::Gemm g{H, WD1, DFF, DFF, DFF, 0}; pg8::StaticOrder S; S.init(M, D, G, bid); EpiResid E{x, out, MOD + 2 * D, 0.5f}; GEMM(EpiResid, g, S, E); }
    SEAM(3);
    if (IN(4)) row_phase<1>(out, out, U, ln_g, ln_b, MOD + 3 * D, MOD + 4 * D, gw, NGW, lane);
    SEAM(4);
    if (IN(5)) { pg8::Gemm g{U, WIN, D, D, D, 0}; pg8::StaticOrder S; S.init(M, INW, G, bid); EpiInProj E{b_in, ROPE, XP, Q, KB, VB, SGA, SGB}; GEMM(EpiInProj, g, S, E); }
    SEAM(5);
    if (IN(6)) { attn_phase(lds, Q, KB, VB, OB, sinks, G, bid); pool_phase(XP, POOLED, gw, NGW, lane); }
    SEAM(6);
    if (IN(7)) { int kp = 256; asm volatile("" : "+s"(kp)); pg8::Gemm g{POOLED, WP, PW, 256, kp, 512}; pg8::StaticOrder S; S.init(M, PW, G, bid); EpiPool E{MIXED, pool_scale}; GEMM(EpiPool, g, S, E); }
    SEAM(7);
    if (IN(8)) {
        { pg8::Gemm g{MIXED, WA, PW, PW, PW, 0}; pg8::StaticOrder S; S.init(M, D, G, bid); EpiGate<0> E{SGA, nullptr, nullptr}; GEMM(EpiGate<0>, g, S, E); }
        { pg8::Gemm g{OB, WB, AW, AW, AW, 0}; pg8::StaticOrder S; S.init(M, D, G, bid); EpiGate<1> E{SGB, SGA, MERGED}; GEMM(EpiGate<1>, g, S, E); }
    }
    SEAM(8);
    if (IN(9)) { pg8::Gemm g{MERGED, WO, D, D, D, 0}; pg8::StaticOrder S; S.init(M, D, G, bid); EpiResid E{out, out, MOD + 5 * D, 1.0f}; GEMM(EpiResid, g, S, E); }
    SEAM(9);
    if (IN(10)) row_phase<1>(out, out, U, ln_g + D, ln_b + D, MOD + 6 * D, MOD + 7 * D, gw, NGW, lane);
    SEAM(10);
    if (IN(11)) { pg8::Gemm g{U, WGU2, D, D, D, 0}; pg8::StaticOrder S; S.init(M, NGU, G, bid); EpiSwiglu E{H}; GEMM(EpiSwiglu, g, S, E); }
    SEAM(11);
    if (IN(12)) { pg8::Gemm g{H, WD2, DFF, DFF, DFF, 0}; pg8::StaticOrder S; S.init(M, D, G, bid); EpiResid E{out, out, MOD + 8 * D, 0.5f}; GEMM(EpiResid, g, S, E); }
    SEAM(12);
    if (IN(13)) row_phase<2>(out, out, nullptr, ln_g + 2 * D, ln_b + 2 * D, nullptr, nullptr, gw, NGW, lane);
#undef IN
#undef SEAM
#undef GEMM
#undef x
#undef c
#undef w_ada
#undef b_ada
#undef ln_g
#undef ln_b
#undef w_ffn1_in
#undef w_ffn1_out
#undef w_in
#undef b_in
#undef w_pool
#undef pool_scale
#undef sinks
#undef w_branch_a
#undef w_branch_b
#undef w_out
#undef w_ffn2_in
#undef w_ffn2_out
#undef out
#undef WSP
#undef MOD
#undef ROPE
#undef WGU1
#undef WD1
#undef WGU2
#undef WD2
#undef WIN
#undef WP
#undef WA
#undef WB
#undef WO
#undef U
#undef MERGED
#undef H
#undef XP
#undef Q
#undef KB
#undef VB
#undef POOLED
#undef MIXED
#undef OB
#undef SGA
#undef SGB
}
}

extern "C" void kernel_launch(void* const* d_in, const int* in_sizes, int n_in, void* d_out, int out_size, void* d_ws, size_t ws_size, hipStream_t stream) {
    using namespace mk;
    static int grid = 0;
    if (grid == 0) {
        if (n_in != 18 || in_sizes[0] != M * D || out_size != M * D || ws_size < WS_END) { fprintf(stderr, "kernel_launch: unexpected shapes (n_in %d, in0 %d, out %d, ws %zu < %zu)\n", n_in, n_in > 0 ? in_sizes[0] : -1, out_size, ws_size, (size_t)WS_END); grid = -1; return; }
        int dev = 0, cus = 0, per_cu = 0;
        if (hipGetDevice(&dev) != hipSuccess || hipDeviceGetAttribute(&cus, hipDeviceAttributeMultiprocessorCount, dev) != hipSuccess) { grid = -1; return; }
        if (hipFuncSetAttribute((const void*)fwd_kernel, hipFuncAttributeMaxDynamicSharedMemorySize, LDS_BYTES) != hipSuccess) { fprintf(stderr, "kernel_launch: hipFuncSetAttribute failed\n"); grid = -1; return; }
        if (hipOccupancyMaxActiveBlocksPerMultiprocessor(&per_cu, (const void*)fwd_kernel, NTHREADS, LDS_BYTES) != hipSuccess || per_cu < 1) { fprintf(stderr, "kernel_launch: occupancy query says %d\n", per_cu); per_cu = 1; }
        (void)hipGetLastError();
        grid = cus * per_cu;
    }
    if (grid < 0) return;
    Args a{};
    for (int i = 0; i < 18; ++i) a.in[i] = (const float*)d_in[i];
    a.out = (float*)d_out; a.ws = (unsigned char*)d_ws;
    for (int j = 0; j < 8; ++j) a.inv_freq[j] = (float)pow(500000.0, -(double)j / 8.0);
#if MK_ONE_LAUNCH
    a.ph_lo = 0; a.ph_hi = N_PHASES;
    if (hipMemsetAsync((char*)d_ws + WS_BAR, 0, WS_BAR_BYTES, stream) != hipSuccess) { fprintf(stderr, "kernel_launch: memset of the barrier words failed\n"); return; }
    void* kargs[] = {&a};
    hipError_t e = hipLaunchCooperativeKernel((const void*)fwd_kernel, dim3(grid), dim3(NTHREADS), kargs, LDS_BYTES, stream);
    if (e != hipSuccess) fprintf(stderr, "kernel_launch: cooperative launch failed: %s (grid %d)\n", hipGetErrorString(e), grid);
#else
    for (int p = 0; p < N_PHASES; ++p) { a.ph_lo = p; a.ph_hi = p + 1; hipLaunchKernelGGL(fwd_kernel, dim3(grid), dim3(NTHREADS), LDS_BYTES, stream, a); }
#endif
}
```

```cpp
#include <hip/hip_runtime.h>
#include <hip/hip_cooperative_groups.h>
#include <cstdio>
#include <cstdint>
#include <cmath>
namespace cg = cooperative_groups;
#ifndef MK_ONE_LAUNCH
#define MK_ONE_LAUNCH 1
#endif
#ifndef MK_REPEAT_MASK
#define MK_REPEAT_MASK 0
#endif
namespace pg8 {
#define PG8_LAS __attribute__((address_space(3)))
typedef unsigned short bf16_t;
typedef short bf16x8 __attribute__((ext_vector_type(8)));
typedef float f32x4 __attribute__((ext_vector_type(4)));
typedef unsigned u32x4 __attribute__((ext_vector_type(4)));
constexpr int BM = 256, BK = 64, HALF = 128, HTB = HALF * BK * 2  , STAGE_BYTES = 8 * HTB, NXCD = 8, WGM = 8;

__host__ __device__ __forceinline__ int lds_byte(int r, int c) { const int st = (r >> 4) * 2 + (c >> 5), rr = r & 15, cc = c & 31, ob = rr * 64 + cc * 2; return st * 1024 + (ob ^ (((ob >> 9) & 1) << 5)); }
__host__ __device__ __forceinline__ void stage_rc(int b, int& R, int& C) { const int st = b / 1024, sb = b % 1024, swz = sb ^ (((sb >> 9) & 1) << 5); R = (st >> 1) * 16 + swz / 64; C = (st & 1) * 32 + (swz % 64) / 2; }
__host__ __device__ __forceinline__ int perm32(int rho) { const int n = rho >> 4, i = rho & 15; return 8 * (i >> 2) + 4 * n + (i & 3); }

struct Unit { int pm, pn; };
struct Gemm { const bf16_t* A; const bf16_t* Bt; int lda, ldb, K; size_t a_pn_bytes; };

struct StaticOrder {
    int nM, nN, nwg, G, c;
    __host__ __device__ void init(int M, int N, int G_, int c_) { nM = M / BM; nN = N / BM; nwg = nM * nN; G = G_; c = c_; }
    __host__ __device__ bool next(int i, Unit& u) const {
        const long L = (long)i * G + c; if (L >= nwg) return false;
        int wgid = (int)L; { const int q = nwg / NXCD, r = nwg % NXCD, xcd = wgid % NXCD, off = wgid / NXCD; wgid = (xcd < r ? xcd * (q + 1) : r * (q + 1) + (xcd - r) * q) + off; }
        const int nig = WGM * nN, gid = wgid / nig, fm = gid * WGM, gsz = (nM - fm) < WGM ? (nM - fm) : WGM;
        u.pm = fm + ((wgid % nig) % gsz); u.pn = (wgid % nig) / gsz; return true;
    }
    __device__ __forceinline__ void a_ready(const Unit&) const {}
    __device__ __forceinline__ void done(const Unit&) const {}
};


template <class Epi, class Sched, bool ALIGN_EPI = false, bool SP2 = false>
__device__ __forceinline__ void gemm_phase(PG8_LAS unsigned char* lds, const Gemm g, const Sched& S, const Epi& E) {
    const int tid = threadIdx.x, wid = __builtin_amdgcn_readfirstlane(tid >> 6), lane = tid & 63, wr = wid >> 2, wc = wid & 3, fr = lane & 15, fq = lane >> 4;
    const int K = g.K, nt = K / BK;
    unsigned voffA[2], voffB[2];
#pragma unroll
    for (int i = 0; i < 2; ++i) { int R, C; stage_rc(tid * 16 + i * 8192, R, C); const int Rb = Epi::PERM ? ((R & ~31) + perm32(R & 31)) : R;
        voffA[i] = (unsigned)(R * g.lda + C) * 2u; voffB[i] = (unsigned)(Rb * g.ldb + C) * 2u; }
    const size_t kstep = (size_t)(BK * 2);
    const size_t hstepA = (size_t)HALF * g.lda * 2, hstepB = (size_t)HALF * g.ldb * 2;
    const size_t tstepA = 2 * hstepA, tstepB = 2 * hstepB;
    const unsigned ldsw = (unsigned)wid * 1024u;
    const int aoff = lds_byte(wr * 64 + fr, fq * 8), boff = lds_byte(wc * 32 + fr, fq * 8);
#define PG8_SA(b, h) (((b) * 2 + (h)) * HTB)
#define PG8_SB(b, h) ((4 + (b) * 2 + (h)) * HTB)
#define PG8_STAGE(bufoff, gbase, voff) do { _Pragma("unroll") for (int _i = 0; _i < 2; ++_i) \
        __builtin_amdgcn_global_load_lds((const unsigned*)((const char*)(gbase) + (voff)[_i]), (PG8_LAS unsigned*)(lds + (bufoff) + ldsw + _i * 8192), 16, 0, 0); } while (0)
#define PG8_LDA(dst, b, h) do { _Pragma("unroll") for (int m = 0; m < 4; ++m) _Pragma("unroll") for (int k = 0; k < 2; ++k) dst[m][k] = *(const PG8_LAS bf16x8*)(lds + PG8_SA(b, h) + aoff + m * 2048 + k * 1024); } while (0)
#define PG8_LDB(dst, b, h) do { _Pragma("unroll") for (int n = 0; n < 2; ++n) _Pragma("unroll") for (int k = 0; k < 2; ++k) dst[n][k] = *(const PG8_LAS bf16x8*)(lds + PG8_SB(b, h) + boff + n * 2048 + k * 1024); } while (0)
#define PG8_MMA(ai, bj, At, Bt) do { __builtin_amdgcn_s_setprio(1); _Pragma("unroll") for (int m = 0; m < 4; ++m) _Pragma("unroll") for (int n = 0; n < 2; ++n) _Pragma("unroll") for (int k = 0; k < 2; ++k) \
        acc[ai][bj][m][n] = __builtin_amdgcn_mfma_f32_16x16x32_bf16(Bt[n][k], At[m][k], acc[ai][bj][m][n], 0, 0, 0); __builtin_amdgcn_s_setprio(0); } while (0)
#define PG8_WAIT_V(n) asm volatile("s_waitcnt vmcnt(" #n ")" ::: "memory")
#define PG8_WAIT_L(n) asm volatile("s_waitcnt lgkmcnt(" #n ")" ::: "memory")
#define PG8_BAR __builtin_amdgcn_s_barrier()
#define PG8_SCHED __builtin_amdgcn_sched_barrier(0)
    Unit cur, nxt; int ui = 0;
    if (!S.next(0, cur)) return;
    f32x4 acc[2][2][4][2];
#pragma unroll
    for (int a = 0; a < 2; ++a)
#pragma unroll
        for (int b = 0; b < 2; ++b)
#pragma unroll
            for (int m = 0; m < 4; ++m)
#pragma unroll
                for (int n = 0; n < 2; ++n) acc[a][b][m][n] = (f32x4){0.f, 0.f, 0.f, 0.f};
    bf16x8 At[4][2], B0[2][2], B1[2][2];
    const char* cA = (const char*)g.A + (size_t)cur.pm * tstepA + (size_t)cur.pn * g.a_pn_bytes; const char* cB = (const char*)g.Bt + (size_t)cur.pn * tstepB;
    S.a_ready(cur);
    if constexpr (SP2) {
        PG8_STAGE(PG8_SB(0, 0), cB, voffB); PG8_STAGE(PG8_SB(0, 1), cB + hstepB, voffB); PG8_STAGE(PG8_SA(0, 0), cA, voffA); PG8_STAGE(PG8_SA(0, 1), cA + hstepA, voffA);
        if (wr == 1) PG8_BAR;
        PG8_WAIT_V(2); PG8_BAR;
        PG8_STAGE(PG8_SB(1, 0), cB + kstep, voffB); PG8_STAGE(PG8_SA(1, 0), cA + kstep, voffA); PG8_STAGE(PG8_SB(1, 1), cB + hstepB + kstep, voffB);
        PG8_WAIT_V(6); PG8_BAR;
    } else {
        PG8_STAGE(PG8_SB(0, 0), cB, voffB); PG8_STAGE(PG8_SA(0, 0), cA, voffA); PG8_STAGE(PG8_SB(0, 1), cB + hstepB, voffB); PG8_STAGE(PG8_SA(0, 1), cA + hstepA, voffA);
        if (wr == 1) PG8_BAR;
        PG8_WAIT_V(4); PG8_BAR;
        PG8_STAGE(PG8_SB(1, 0), cB + kstep, voffB); PG8_STAGE(PG8_SA(1, 0), cA + kstep, voffA); PG8_STAGE(PG8_SB(1, 1), cB + hstepB + kstep, voffB);
        PG8_WAIT_V(6); PG8_BAR;
    }
    for (;;) {
        const bool has_next = S.next(ui + 1, nxt);
        const char* nA = has_next ? (const char*)g.A + (size_t)nxt.pm * tstepA + (size_t)nxt.pn * g.a_pn_bytes : cA; const char* nB = has_next ? (const char*)g.Bt + (size_t)nxt.pn * tstepB : cB;
        for (int t = 0; t < nt; t += 2) {
            const bool last = (t == nt - 2);
            const char* a1 = cA + (size_t)(t + 1) * kstep;
            const char* a2 = last ? nA : cA + (size_t)(t + 2) * kstep; const char* b2 = last ? nB : cB + (size_t)(t + 2) * kstep;
            const char* a3 = a2 + kstep; const char* b3 = b2 + kstep;
            if (last && has_next) S.a_ready(nxt);
            if constexpr (SP2) {
            PG8_LDB(B0, 0, 0); PG8_LDB(B1, 0, 1); PG8_SCHED; PG8_LDA(At, 0, 0); PG8_STAGE(PG8_SA(1, 1), a1 + hstepA, voffA);
            PG8_WAIT_V(8); PG8_WAIT_L(0); PG8_BAR; PG8_MMA(0, 0, At, B0); PG8_MMA(0, 1, At, B1); PG8_BAR; PG8_SCHED;
            PG8_LDA(At, 0, 1); PG8_STAGE(PG8_SB(0, 0), b2, voffB); PG8_STAGE(PG8_SB(0, 1), b2 + hstepB, voffB); PG8_STAGE(PG8_SA(0, 0), a2, voffA);
            PG8_WAIT_V(8); PG8_WAIT_L(0); PG8_BAR; PG8_MMA(1, 0, At, B0); PG8_MMA(1, 1, At, B1); PG8_BAR; PG8_SCHED;
            PG8_LDB(B0, 1, 0); PG8_LDB(B1, 1, 1); PG8_SCHED; PG8_LDA(At, 1, 0); PG8_STAGE(PG8_SA(0, 1), a2 + hstepA, voffA);
            PG8_WAIT_V(8); PG8_WAIT_L(0); PG8_BAR; PG8_MMA(0, 0, At, B0); PG8_MMA(0, 1, At, B1); PG8_BAR; PG8_SCHED;
            PG8_LDA(At, 1, 1); PG8_STAGE(PG8_SB(1, 0), b3, voffB); PG8_STAGE(PG8_SB(1, 1), b3 + hstepB, voffB); PG8_STAGE(PG8_SA(1, 0), a3, voffA);
            PG8_WAIT_V(8); PG8_WAIT_L(0); PG8_BAR; PG8_MMA(1, 0, At, B0); PG8_MMA(1, 1, At, B1); PG8_BAR; PG8_SCHED;
            } else {
            PG8_LDB(B0, 0, 0); PG8_SCHED; PG8_LDA(At, 0, 0); PG8_STAGE(PG8_SA(1, 1), a1 + hstepA, voffA);
            PG8_WAIT_L(8); PG8_BAR; PG8_WAIT_L(0); PG8_MMA(0, 0, At, B0); PG8_BAR; PG8_SCHED;
            PG8_LDB(B1, 0, 1); PG8_STAGE(PG8_SB(0, 0), b2, voffB);
            PG8_BAR; PG8_WAIT_L(0); PG8_MMA(0, 1, At, B1); PG8_BAR;
            PG8_LDA(At, 0, 1); PG8_STAGE(PG8_SA(0, 0), a2, voffA);
            PG8_BAR; PG8_WAIT_L(0); PG8_MMA(1, 0, At, B0); PG8_BAR; PG8_SCHED;
            PG8_STAGE(PG8_SB(0, 1), b2 + hstepB, voffB);
            PG8_WAIT_V(6); PG8_BAR; PG8_MMA(1, 1, At, B1); PG8_BAR;
            PG8_LDB(B0, 1, 0); PG8_SCHED; PG8_LDA(At, 1, 0); PG8_STAGE(PG8_SA(0, 1), a2 + hstepA, voffA);
            PG8_WAIT_L(8); PG8_BAR; PG8_WAIT_L(0); PG8_MMA(0, 0, At, B0); PG8_BAR; PG8_SCHED;
            PG8_LDB(B1, 1, 1); PG8_STAGE(PG8_SB(1, 0), b3, voffB);
            PG8_BAR; PG8_WAIT_L(0); PG8_MMA(0, 1, At, B1); PG8_BAR;
            PG8_LDA(At, 1, 1); PG8_STAGE(PG8_SA(1, 0), a3, voffA);
            PG8_BAR; PG8_WAIT_L(0); PG8_MMA(1, 0, At, B0); PG8_BAR; PG8_SCHED;
            PG8_STAGE(PG8_SB(1, 1), b3 + hstepB, voffB);
            PG8_WAIT_V(6); PG8_BAR; PG8_MMA(1, 1, At, B1); PG8_BAR;
            }
        }
        if constexpr (ALIGN_EPI) { if (wr == 0) PG8_BAR; }
        if constexpr (!Epi::AFTER_DRAIN) { E(acc, cur, wr, wc, fr, fq); S.done(cur); }
        if (!has_next) break;
#pragma unroll
        for (int a = 0; a < 2; ++a)
#pragma unroll
            for (int b = 0; b < 2; ++b)
#pragma unroll
                for (int m = 0; m < 4; ++m)
#pragma unroll
                    for (int n = 0; n < 2; ++n) acc[a][b][m][n] = (f32x4){0.f, 0.f, 0.f, 0.f};
        cur = nxt; cA = nA; cB = nB; ++ui;
        if constexpr (ALIGN_EPI) { if (wr == 1) PG8_BAR; }
    }
    PG8_WAIT_V(0);
    if constexpr (!ALIGN_EPI) { if (wr == 0) PG8_BAR; }
    PG8_BAR;
    if constexpr (Epi::AFTER_DRAIN) { E.fused(acc, cur, wr, wc, fr, fq, lds, wid, lane); S.done(cur); }
#undef PG8_SA
#undef PG8_SB
#undef PG8_STAGE
#undef PG8_LDA
#undef PG8_LDB
#undef PG8_MMA
#undef PG8_WAIT_V
#undef PG8_WAIT_L
#undef PG8_BAR
#undef PG8_SCHED
}
}

namespace mk {
using pg8::bf16_t; using pg8::f32x4; using pg8::u32x4; using pg8::bf16x8; using pg8::Unit;
#define LAS __attribute__((address_space(3)))
typedef float f32x16 __attribute__((ext_vector_type(16)));
typedef short s16x4 __attribute__((ext_vector_type(4)));
typedef unsigned u32x2 __attribute__((ext_vector_type(2)));
typedef __bf16 bf16x2_t __attribute__((ext_vector_type(2)));
typedef float f32x2_t __attribute__((ext_vector_type(2)));

constexpr int D = 2048, BATCH = 4, SEQ = 4096, M = BATCH * SEQ, DFF = 5504, NGU = 2 * DFF, INW = 6656, PW = 1024, AW = 1024, KVW = 256, NMOD = 9 * D;
constexpr float ALPHA = 1.189207115002721f;
constexpr float LN_EPS = 1e-5f, LOG2E = 1.4426950408889634f;
constexpr int NWAVES = 8, NTHREADS = 512;
constexpr int LDS_BYTES = 147456;

constexpr size_t MiB = 1u << 20;
constexpr size_t WS_MOD = 0;
constexpr size_t WS_BAR = 384 * 1024, WS_BAR_BYTES = 16384;
constexpr size_t WS_ROPE = 512 * 1024;
constexpr size_t WS_WGU1 = 2 * MiB;
constexpr size_t WS_WD1 = WS_WGU1 + 43 * MiB;
constexpr size_t WS_WGU2 = WS_WD1 + 22 * MiB;
constexpr size_t WS_WD2 = WS_WGU2 + 43 * MiB;
constexpr size_t WS_WIN = WS_WD2 + 22 * MiB;
constexpr size_t WS_WP = WS_WIN + 26 * MiB;
constexpr size_t WS_WA = WS_WP + 1 * MiB;
constexpr size_t WS_WB = WS_WA + 4 * MiB;
constexpr size_t WS_WO = WS_WB + 4 * MiB;
constexpr size_t WS_U = WS_WO + 8 * MiB;
constexpr size_t WS_BIG = WS_U + 64 * MiB;
constexpr size_t WS_XP = WS_BIG, WS_Q = WS_XP + 32 * MiB, WS_K = WS_Q + 32 * MiB, WS_V = WS_K + 8 * MiB, WS_POOLED = WS_V + 8 * MiB, WS_MIXED = WS_POOLED + 32 * MiB, WS_O = WS_MIXED + 32 * MiB;
constexpr size_t WS_SGA = WS_BIG + 176 * MiB;
constexpr size_t WS_SGB = WS_SGA + 64 * MiB;
constexpr size_t WS_END = WS_SGB + 64 * MiB;
static_assert(WS_O + 32 * MiB <= WS_SGA && (size_t)M * DFF * 2 <= 176 * MiB && (size_t)D * DFF * 2 <= 22 * MiB, "ws map");

__device__ __forceinline__ unsigned pk_bf16(float lo, float hi) { f32x2_t v = {lo, hi}; bf16x2_t b = __builtin_convertvector(v, bf16x2_t); return __builtin_bit_cast(unsigned, b); }
__device__ __forceinline__ float bf_lo(unsigned w) { return __builtin_bit_cast(float, w << 16); }
__device__ __forceinline__ float bf_hi(unsigned w) { return __builtin_bit_cast(float, w & 0xffff0000u); }
__device__ __forceinline__ float sigmoid_f(float a) { return __builtin_amdgcn_rcpf(1.0f + __builtin_amdgcn_exp2f(-LOG2E * a)); }
__device__ __forceinline__ float silu_f(float a) { return a * sigmoid_f(a); }
__device__ __forceinline__ u32x4 pk8(const f32x4 v0, const f32x4 v1) { u32x4 w; w.x = pk_bf16(v0[0], v0[1]); w.y = pk_bf16(v0[2], v0[3]); w.z = pk_bf16(v1[0], v1[1]); w.w = pk_bf16(v1[2], v1[3]); return w; }

struct EpiSwiglu {
    static constexpr bool PERM = true, AFTER_DRAIN = false;
    bf16_t* H;
    __device__ __forceinline__ void operator()(const f32x4 (&acc)[2][2][4][2], const Unit& u, int wr, int wc, int fr, int fq) const {
        const int row0 = u.pm * 256 + wr * 64 + fr, col0 = u.pn * 128 + wc * 32 + 8 * fq;
#pragma unroll
        for (int ai = 0; ai < 2; ++ai)
#pragma unroll
            for (int m = 0; m < 4; ++m) { bf16_t* rowp = H + (size_t)(row0 + ai * 128 + m * 16) * DFF + col0;
                const f32x4 a0 = acc[ai][0][m][0], a1 = acc[ai][0][m][1];
                f32x4 e0 = a0 * (-LOG2E), e1 = a1 * (-LOG2E);
#pragma unroll
                for (int e = 0; e < 4; ++e) { e0[e] = __builtin_amdgcn_exp2f(e0[e]); e1[e] = __builtin_amdgcn_exp2f(e1[e]); }
                e0 = e0 + 1.0f; e1 = e1 + 1.0f;
#pragma unroll
                for (int e = 0; e < 4; ++e) { e0[e] = __builtin_amdgcn_rcpf(e0[e]); e1[e] = __builtin_amdgcn_rcpf(e1[e]); }
                const f32x4 h0 = (a0 * acc[ai][1][m][0]) * e0, h1 = (a1 * acc[ai][1][m][1]) * e1;
                *(u32x4*)rowp = pk8(h0, h1); }
    }
};
struct EpiResid {
    static constexpr bool PERM = false, AFTER_DRAIN = false;
    const float* xin; float* zout; const float* gate; float w;
    __device__ __forceinline__ void operator()(const f32x4 (&acc)[2][2][4][2], const Unit& u, int wr, int wc, int fr, int fq) const {
        const int row0 = u.pm * 256 + wr * 64 + fr, col0 = u.pn * 256 + wc * 32 + 4 * fq;
        const float* gp = gate + (size_t)(u.pm >> 4) * NMOD + col0;
        f32x4 gv[2][2];
#pragma unroll
        for (int bj = 0; bj < 2; ++bj)
#pragma unroll
            for (int n = 0; n < 2; ++n) gv[bj][n] = (*(const f32x4*)(gp + bj * 128 + n * 16) + 1.0f) * w;
#pragma unroll
        for (int ai = 0; ai < 2; ++ai)
#pragma unroll
            for (int m = 0; m < 4; ++m) { const size_t off = (size_t)(row0 + ai * 128 + m * 16) * D + col0;
#pragma unroll
                for (int bj = 0; bj < 2; ++bj)
#pragma unroll
                    for (int n = 0; n < 2; ++n) { const f32x4 xv = *(const f32x4*)(xin + off + bj * 128 + n * 16);
                        *(f32x4*)(zout + off + bj * 128 + n * 16) = xv * ALPHA + gv[bj][n] * acc[ai][bj][m][n]; }
                asm volatile("" ::: "memory"); }
    }
};
struct EpiInProj {
    static constexpr bool PERM = true, AFTER_DRAIN = false;
    const float* bias; const float* rope; bf16_t *XP, *Q, *Kb, *Vb, *SGA, *SGB;
    __device__ __forceinline__ void operator()(const f32x4 (&acc)[2][2][4][2], const Unit& u, int wr, int wc, int fr, int fq) const {
        const int pn = u.pn; bf16_t* base; int ld, colt, mode; float sc = 1.f;
        if (pn < 4) { base = XP; ld = PW; colt = pn * 256; mode = 0; }
        else if (pn < 8) { base = Q; ld = AW; colt = (pn - 4) * 256; mode = 1; sc = 0.125f; }
        else if (pn == 8) { base = Kb; ld = KVW; colt = 0; mode = 1; }
        else if (pn == 9) { base = Vb; ld = KVW; colt = 0; mode = 0; }
        else if (pn < 18) { base = SGA; ld = D; colt = (pn - 10) * 256; mode = 2; }
        else { base = SGB; ld = D; colt = (pn - 18) * 256; mode = 2; }
        const int row0 = u.pm * 256 + wr * 64 + fr, col0 = colt + wc * 32 + 8 * fq, bcol0 = pn * 256 + wc * 32 + 8 * fq;
        f32x4 bv[2][2];
#pragma unroll
        for (int bj = 0; bj < 2; ++bj)
#pragma unroll
            for (int n = 0; n < 2; ++n) bv[bj][n] = *(const f32x4*)(bias + bcol0 + bj * 128 + 4 * n);
        const bool dorope = (mode == 1) && ((wc & 1) == 0);
        const float sg = (fq == 0) ? -1.f : 1.f;
#pragma unroll
        for (int ai = 0; ai < 2; ++ai)
#pragma unroll
            for (int m = 0; m < 4; ++m) { const int row = row0 + ai * 128 + m * 16;
                f32x4 c0 = {1.f, 1.f, 1.f, 1.f}, c1 = c0, s0 = {0.f, 0.f, 0.f, 0.f}, s1 = s0;
                if (dorope && fq < 2) { const float* rp = rope + (size_t)(row & (SEQ - 1)) * 16; c0 = *(const f32x4*)rp; c1 = *(const f32x4*)(rp + 4); s0 = *(const f32x4*)(rp + 8) * sg; s1 = *(const f32x4*)(rp + 12) * sg; }
#pragma unroll
                for (int bj = 0; bj < 2; ++bj) { f32x4 v0 = acc[ai][bj][m][0] + bv[bj][0], v1 = acc[ai][bj][m][1] + bv[bj][1];
                    if (dorope) { f32x4 p0, p1;
#pragma unroll
                        for (int e = 0; e < 4; ++e) { p0[e] = __shfl_xor(v0[e], 16); p1[e] = __shfl_xor(v1[e], 16); }
                        v0 = v0 * c0 + p0 * s0; v1 = v1 * c1 + p1 * s1; }
                    if (mode == 2) {
#pragma unroll
                        for (int e = 0; e < 4; ++e) { v0[e] = sigmoid_f(v0[e]); v1[e] = sigmoid_f(v1[e]); } }
                    v0 = v0 * sc; v1 = v1 * sc;
                    *(u32x4*)(base + (size_t)row * ld + col0 + bj * 128) = pk8(v0, v1); } }
    }
};
struct EpiPool {
    static constexpr bool PERM = true, AFTER_DRAIN = false;
    bf16_t* O; const float* scale;
    __device__ __forceinline__ void operator()(const f32x4 (&acc)[2][2][4][2], const Unit& u, int wr, int wc, int fr, int fq) const {
        const int row0 = u.pm * 256 + wr * 64 + fr, col0 = u.pn * 256 + wc * 32 + 8 * fq;
        f32x4 sv[2][2];
#pragma unroll
        for (int bj = 0; bj < 2; ++bj)
#pragma unroll
            for (int n = 0; n < 2; ++n) sv[bj][n] = *(const f32x4*)(scale + col0 + bj * 128 + 4 * n);
#pragma unroll
        for (int ai = 0; ai < 2; ++ai)
#pragma unroll
            for (int m = 0; m < 4; ++m) { bf16_t* rowp = O + (size_t)(row0 + ai * 128 + m * 16) * PW + col0;
#pragma unroll
                for (int bj = 0; bj < 2; ++bj) *(u32x4*)(rowp + bj * 128) = pk8(acc[ai][bj][m][0] * sv[bj][0], acc[ai][bj][m][1] * sv[bj][1]); }
    }
};
template <int MODE> struct EpiGate {
    static constexpr bool PERM = true, AFTER_DRAIN = false;
    bf16_t* G; const bf16_t* YA; bf16_t* OUT;
    __device__ __forceinline__ void operator()(const f32x4 (&acc)[2][2][4][2], const Unit& u, int wr, int wc, int fr, int fq) const {
        const int row0 = u.pm * 256 + wr * 64 + fr, col0 = u.pn * 256 + wc * 32 + 8 * fq;
#pragma unroll
        for (int ai = 0; ai < 2; ++ai)
#pragma unroll
            for (int m = 0; m < 4; ++m) { const size_t off = (size_t)(row0 + ai * 128 + m * 16) * D + col0;
#pragma unroll
                for (int bj = 0; bj < 2; ++bj) { const u32x4 gw = *(const u32x4*)(G + off + bj * 128);
                    f32x4 v0 = {bf_lo(gw.x), bf_hi(gw.x), bf_lo(gw.y), bf_hi(gw.y)}, v1 = {bf_lo(gw.z), bf_hi(gw.z), bf_lo(gw.w), bf_hi(gw.w)};
                    v0 = v0 * acc[ai][bj][m][0]; v1 = v1 * acc[ai][bj][m][1];
                    if (MODE == 1) { const u32x4 yw = *(const u32x4*)(YA + off + bj * 128);
                        v0 += (f32x4){bf_lo(yw.x), bf_hi(yw.x), bf_lo(yw.y), bf_hi(yw.y)}; v1 += (f32x4){bf_lo(yw.z), bf_hi(yw.z), bf_lo(yw.w), bf_hi(yw.w)};
                        *(u32x4*)(OUT + off + bj * 128) = pk8(v0, v1); }
                    else *(u32x4*)(G + off + bj * 128) = pk8(v0, v1); }
                asm volatile("" ::: "memory"); }
    }
};

#define MFMA32(a, b, c) __builtin_amdgcn_mfma_f32_32x32x16_bf16((a), (b), (c), 0, 0, 0)
constexpr int KS_PITCH = 144, VT_PITCH = 260  , ATT_VT_OFF = 256 * KS_PITCH;
__device__ __forceinline__ void attn_phase(LAS unsigned char* lds, const bf16_t* Q, const bf16_t* Kb, const bf16_t* Vb, bf16_t* O, const float* sinks, int G, int bid) {
    const int tid = threadIdx.x, lane = tid & 63, wid = __builtin_amdgcn_readfirstlane(tid >> 6), r = lane & 31, h = lane >> 5;
    LAS unsigned char* Ks = lds;
    LAS bf16_t* Vt = (LAS bf16_t*)(lds + ATT_VT_OFF);
    const int rg = wid & 3, hp = wid >> 2;
    for (int item = bid; item < BATCH * 4 * 32; item += G) {
        const int qblk = item & 31, kvh = (item >> 5) & 3, b = item >> 7;
        const long tokbase = (long)b * SEQ + qblk * 128 - 128;
#pragma unroll
        for (int i = 0; i < 4; ++i) { const int cid = tid + 512 * i;
            { const int key = cid >> 3, part = cid & 7; u32x4 v = {0u, 0u, 0u, 0u};
              if (qblk > 0 || key >= 128) v = *(const u32x4*)(Kb + (size_t)(tokbase + key) * KVW + kvh * 64 + part * 8);
              *(LAS u32x4*)(Ks + key * KS_PITCH + part * 16) = v; }
            { const int key = cid & 255, part = cid >> 8; u32x4 v = {0u, 0u, 0u, 0u};
              if (qblk > 0 || key >= 128) v = *(const u32x4*)(Vb + (size_t)(tokbase + key) * KVW + kvh * 64 + part * 8);
              LAS bf16_t* vp = Vt + (part * 8) * VT_PITCH + key;
              vp[0 * VT_PITCH] = (bf16_t)(v.x & 0xffffu); vp[1 * VT_PITCH] = (bf16_t)(v.x >> 16); vp[2 * VT_PITCH] = (bf16_t)(v.y & 0xffffu); vp[3 * VT_PITCH] = (bf16_t)(v.y >> 16);
              vp[4 * VT_PITCH] = (bf16_t)(v.z & 0xffffu); vp[5 * VT_PITCH] = (bf16_t)(v.z >> 16); vp[6 * VT_PITCH] = (bf16_t)(v.w & 0xffffu); vp[7 * VT_PITCH] = (bf16_t)(v.w >> 16); }
        }
        __syncthreads();
#pragma unroll 1
        for (int hh = 0; hh < 2; ++hh) {
            const int qh = kvh * 4 + hp * 2 + hh;
            const size_t tok = (size_t)b * SEQ + qblk * 128 + 32 * rg + r;
            const float sink = sinks[qh];
            bf16x8 qf[4];
#pragma unroll
            for (int s = 0; s < 4; ++s) qf[s] = *(const bf16x8*)(Q + tok * AW + qh * 64 + 16 * s + 8 * h);
            f32x16 S[5];
            float mx = -1e30f;
#pragma unroll
            for (int t = 0; t < 5; ++t) {
                f32x16 a;
#pragma unroll
                for (int i = 0; i < 16; ++i) a[i] = 0.f;
                const LAS unsigned char* kp = Ks + (32 * (rg + t) + r) * KS_PITCH + 16 * h;
#pragma unroll
                for (int s = 0; s < 4; ++s) a = MFMA32(*(const LAS bf16x8*)(kp + 32 * s), qf[s], a);
                const bool dead = (qblk == 0) && (rg + t < 4);
#pragma unroll
                for (int i = 0; i < 16; ++i) { const int cr = (i & 3) + 8 * (i >> 2) + 4 * h;
                    bool valid = !dead; if (t == 0) valid = valid && (cr > r); if (t == 4) valid = valid && (cr <= r);
                    const float sv = valid ? a[i] : -1e30f; a[i] = sv; mx = fmaxf(mx, sv); }
                S[t] = a; __builtin_amdgcn_sched_barrier(0);
            }
            mx = fmaxf(mx, __shfl_xor(mx, 32)); mx = fmaxf(mx, sink);
            float sum = 0.f; const float mxl = mx * LOG2E;
#pragma unroll
            for (int t = 0; t < 5; ++t)
#pragma unroll
                for (int i = 0; i < 16; ++i) { const float p = __builtin_amdgcn_exp2f(S[t][i] * LOG2E - mxl); S[t][i] = p; sum += p; }
            sum += __shfl_xor(sum, 32); sum += __builtin_amdgcn_exp2f(sink * LOG2E - mxl);
            const float inv = 1.0f / sum;
            f32x16 o0, o1;
#pragma unroll
            for (int i = 0; i < 16; ++i) { o0[i] = 0.f; o1[i] = 0.f; }
#pragma unroll
            for (int t = 0; t < 5; ++t)
#pragma unroll
                for (int s2 = 0; s2 < 2; ++s2) {
                    u32x4 pw; pw.x = pk_bf16(S[t][8 * s2 + 0], S[t][8 * s2 + 1]); pw.y = pk_bf16(S[t][8 * s2 + 2], S[t][8 * s2 + 3]); pw.z = pk_bf16(S[t][8 * s2 + 4], S[t][8 * s2 + 5]); pw.w = pk_bf16(S[t][8 * s2 + 6], S[t][8 * s2 + 7]);
                    const bf16x8 pf = __builtin_bit_cast(bf16x8, pw);
                    const LAS bf16_t* vp = Vt + r * VT_PITCH + 32 * (rg + t) + 16 * s2 + 4 * h;
                    const s16x4 a0 = *(const LAS s16x4*)vp, a1 = *(const LAS s16x4*)(vp + 8), b0 = *(const LAS s16x4*)(vp + 32 * VT_PITCH), b1 = *(const LAS s16x4*)(vp + 32 * VT_PITCH + 8);
                    o0 = MFMA32(__builtin_shufflevector(a0, a1, 0, 1, 2, 3, 4, 5, 6, 7), pf, o0);
                    o1 = MFMA32(__builtin_shufflevector(b0, b1, 0, 1, 2, 3, 4, 5, 6, 7), pf, o1);
                    __builtin_amdgcn_sched_barrier(0);
                }
            bf16_t* op = O + tok * AW + qh * 64 + 4 * h;
#pragma unroll
            for (int g = 0; g < 4; ++g) {
                u32x2 w0, w1; w0.x = pk_bf16(o0[4 * g] * inv, o0[4 * g + 1] * inv); w0.y = pk_bf16(o0[4 * g + 2] * inv, o0[4 * g + 3] * inv);
                w1.x = pk_bf16(o1[4 * g] * inv, o1[4 * g + 1] * inv); w1.y = pk_bf16(o1[4 * g + 2] * inv, o1[4 * g + 3] * inv);
                *(u32x2*)(op + 8 * g) = w0; *(u32x2*)(op + 32 + 8 * g) = w1; }
        }
        __syncthreads();
    }
}

__device__ __forceinline__ void pool_phase(const bf16_t* XP, bf16_t* P, int gw, int NGW, int lane) {
    for (int it = gw; it < 2 * M; it += NGW) {
        const int row = it >> 1, c0 = (it & 1) * 512 + lane * 8, g = c0 >> 8, w = 2 << g, pos = row & (SEQ - 1);
        const int cnt = (pos + 1 < w) ? pos + 1 : w;
        const bf16_t* src = XP + (size_t)row * PW + c0;
        float a[8];
#pragma unroll
        for (int e = 0; e < 8; ++e) a[e] = 0.f;
        const u32x4 x0 = *(const u32x4*)src;
        for (int j = 1; j < cnt; ++j) { const u32x4 v = *(const u32x4*)(src - (size_t)j * PW);
            a[0] += bf_lo(v.x); a[1] += bf_hi(v.x); a[2] += bf_lo(v.y); a[3] += bf_hi(v.y); a[4] += bf_lo(v.z); a[5] += bf_hi(v.z); a[6] += bf_lo(v.w); a[7] += bf_hi(v.w); }
        const float xs[8] = {bf_lo(x0.x), bf_hi(x0.x), bf_lo(x0.y), bf_hi(x0.y), bf_lo(x0.z), bf_hi(x0.z), bf_lo(x0.w), bf_hi(x0.w)};
        const float ic = 1.0f / (float)cnt; float o[8];
#pragma unroll
        for (int e = 0; e < 8; ++e) o[e] = (a[e] + xs[e]) * ic - xs[e];
        u32x4 ow; ow.x = pk_bf16(o[0], o[1]); ow.y = pk_bf16(o[2], o[3]); ow.z = pk_bf16(o[4], o[5]); ow.w = pk_bf16(o[6], o[7]);
        *(u32x4*)(P + (size_t)row * PW + c0) = ow;
    }
}

__device__ __forceinline__ float wave_sum(float v) {
#pragma unroll
    for (int o = 1; o < 64; o <<= 1) v += __shfl_xor(v, o);
    return v;
}
template <int MODE> __device__ __forceinline__ void row_phase(const float* xin, float* xout, bf16_t* U, const float* lng, const float* lnb, const float* shift, const float* scale, int gw, int NGW, int lane) {
    for (int row = gw; row < M; row += NGW) {
        const f32x4* xr = (const f32x4*)(xin + (size_t)row * D) + lane;
        f32x4 v[8];
#pragma unroll
        for (int j = 0; j < 8; ++j) v[j] = xr[64 * j];
        if (MODE != 0) {
            float s = 0.f;
#pragma unroll
            for (int j = 0; j < 8; ++j) s += (v[j][0] + v[j][1]) + (v[j][2] + v[j][3]);
            const float mean = wave_sum(s) * (1.0f / D); float s2 = 0.f;
#pragma unroll
            for (int j = 0; j < 8; ++j) { v[j] = v[j] - mean; s2 += (v[j][0] * v[j][0] + v[j][1] * v[j][1]) + (v[j][2] * v[j][2] + v[j][3] * v[j][3]); }
            const float rstd = 1.0f / sqrtf(wave_sum(s2) * (1.0f / D) + LN_EPS);
            f32x4* xo = (f32x4*)(xout + (size_t)row * D) + lane;
#pragma unroll
            for (int j = 0; j < 8; ++j) { const f32x4 gg = *((const f32x4*)lng + lane + 64 * j), bb = *((const f32x4*)lnb + lane + 64 * j); v[j] = v[j] * rstd * gg + bb; xo[64 * j] = v[j]; }
        }
        if (MODE != 2) {
            const int b = row >> 12;
            const f32x4* sh = (const f32x4*)(shift + (size_t)b * NMOD) + lane; const f32x4* sc = (const f32x4*)(scale + (size_t)b * NMOD) + lane;
            u32x2* uo = (u32x2*)(U + (size_t)row * D) + lane;
#pragma unroll
            for (int j = 0; j < 8; ++j) { const f32x4 t = v[j] * (sc[64 * j] + 1.0f) + sh[64 * j]; u32x2 w; w.x = pk_bf16(t[0], t[1]); w.y = pk_bf16(t[2], t[3]); uo[64 * j] = w; }
        }
    }
}

__device__ __forceinline__ void transpose_item(const float* W, int K, int N, bf16_t* WT, int k0, int n0, int drow0, LAS float* scr, int lane) {
    float tv[32];
    const float* wp = W + (size_t)(k0 + (lane >> 5)) * N + n0 + (lane & 31);
#pragma unroll
    for (int i = 0; i < 32; ++i) tv[i] = wp[(size_t)(2 * i) * N];
#pragma unroll
    for (int i = 0; i < 32; ++i) scr[(2 * i + (lane >> 5)) * 33 + (lane & 31)] = tv[i];
    asm volatile("s_waitcnt lgkmcnt(0)" ::: "memory");
    const int c = lane & 7;
#pragma unroll
    for (int j = 0; j < 4; ++j) { const int n = (lane >> 3) + 8 * j; const LAS float* s = scr + (8 * c) * 33 + n;
        u32x4 o; o.x = pk_bf16(s[0 * 33], s[1 * 33]); o.y = pk_bf16(s[2 * 33], s[3 * 33]); o.z = pk_bf16(s[4 * 33], s[5 * 33]); o.w = pk_bf16(s[6 * 33], s[7 * 33]);
        *(u32x4*)(WT + (size_t)(drow0 + n) * K + k0 + 8 * c) = o; }
    asm volatile("s_waitcnt lgkmcnt(0)" ::: "memory");
}
__device__ __forceinline__ void transpose_plain(const float* W, int K, int N, bf16_t* WT, int item, LAS float* scr, int lane) {
    const int nblk = N / 32, kb = item / nblk, nb = item % nblk; transpose_item(W, K, N, WT, 64 * kb, 32 * nb, 32 * nb, scr, lane);
}
__device__ __forceinline__ void transpose_gu(const float* W, bf16_t* WT, int item, LAS float* scr, int lane) {
    const int nblk = NGU / 32, kb = item / nblk, nb = item % nblk, n0 = 32 * nb, bj = n0 / DFF, rem = n0 - bj * DFF, pn = rem >> 7, i0 = rem & 127;
    transpose_item(W, D, NGU, WT, 64 * kb, n0, 256 * pn + 128 * bj + i0, scr, lane);
}

#define RLX_AGENT __ATOMIC_RELAXED, __HIP_MEMORY_SCOPE_AGENT
#define XB_TMO      128
#define XB_XCNT(j)  (256  + 64 * (j))
#define XB_XSUB(j)  (1280 + 64 * (j))
#define XB_XGEN(j)  (2304 + 64 * (j))
#define XB_TOP      3328
#define XB_TOPGEN   3392
#define XCD_BAR_WORDS 3456
#define XB_SPIN_CAP (1u << 18)

__device__ __forceinline__ unsigned xb_ld(unsigned* p)              { return __hip_atomic_load(p, __ATOMIC_RELAXED, __HIP_MEMORY_SCOPE_AGENT); }
__device__ __forceinline__ unsigned xb_add(unsigned* p, unsigned v) { return __hip_atomic_fetch_add(p, v, __ATOMIC_RELAXED, __HIP_MEMORY_SCOPE_AGENT); }
__device__ __forceinline__ unsigned xb_xcc_id() { return (unsigned)__builtin_amdgcn_s_getreg((3 << 11) | 20) & 0xFu; }
#define XB_SPIN(cond, bar) do { unsigned _sp = 0; while (cond) { __builtin_amdgcn_s_sleep(1); \
    if ((++_sp & 255u) == 0u) { if (xb_ld(&(bar)[XB_TMO])) break; if (_sp > XB_SPIN_CAP) { atomicAdd(&(bar)[XB_TMO], 1u); break; } } } } while (0)

struct XcdBarrier {
    unsigned* bar; unsigned x;
    volatile LAS unsigned* st;
};

__device__ __forceinline__ XcdBarrier xcd_barrier_post(unsigned* bar, volatile LAS unsigned* st) {
    XcdBarrier b; b.bar = bar; b.x = xb_xcc_id(); b.st = st;
    if (threadIdx.x == 0) (void)xb_add(&bar[XB_XCNT(b.x)], 1u);
    return b;
}
__device__ __forceinline__ void xcd_barrier_complete(unsigned* bar, unsigned x, unsigned& nloc, unsigned& nx) {
    const unsigned G = gridDim.x * gridDim.y * gridDim.z;
    unsigned sum, cnt, mine, sp = 0u;
    for (;;) {
        sum = 0u; cnt = 0u; mine = 0u;
#pragma unroll
        for (unsigned j = 0; j < 16; ++j) { const unsigned c = xb_ld(&bar[XB_XCNT(j)]); sum += c; cnt += (c > 0u) ? 1u : 0u; mine = (j == x) ? c : mine; }
        if (sum == G) break;
        __builtin_amdgcn_s_sleep(1);
        if ((++sp & 255u) == 0u) { if (xb_ld(&bar[XB_TMO])) break; if (sp > XB_SPIN_CAP) { atomicAdd(&bar[XB_TMO], 1u); break; } }
    }
    nloc = mine > 0u ? mine : 1u; nx = cnt > 0u ? cnt : 1u;
}

__device__ __forceinline__ void xcd_barrier(const XcdBarrier& b) {
    asm volatile("s_waitcnt vmcnt(0)" ::: "memory");
    __syncthreads();
    if (threadIdx.x == 0) {
        unsigned* bar = b.bar;
        __builtin_amdgcn_s_waitcnt(0);
        unsigned nloc = b.st[0], nx = b.st[1];
        if (nloc == 0u) { xcd_barrier_complete(bar, b.x, nloc, nx); b.st[0] = nloc; b.st[1] = nx; }
        const unsigned old = xb_add(&bar[XB_XSUB(b.x)], 1u);
        const unsigned gen = old / nloc;
        if (old + 1u == (gen + 1u) * nloc) {
            __builtin_amdgcn_fence(__ATOMIC_RELEASE, "agent");
            asm volatile("s_waitcnt vmcnt(0)" ::: "memory");
            const unsigned og = xb_add(&bar[XB_TOP], 1u);
            const unsigned tg = og / nx;
            if (og + 1u == (tg + 1u) * nx) xb_add(&bar[XB_TOPGEN], 1u);
            else XB_SPIN(xb_ld(&bar[XB_TOPGEN]) == tg, bar);
            __builtin_amdgcn_fence(__ATOMIC_ACQUIRE, "agent");
            xb_add(&bar[XB_XGEN(b.x)], 1u);
            asm volatile("s_waitcnt vmcnt(0)" ::: "memory");
        } else {
            XB_SPIN(xb_ld(&bar[XB_XGEN(b.x)]) == gen, bar);
            __builtin_amdgcn_fence(__ATOMIC_ACQUIRE, "agent");
            asm volatile("s_waitcnt vmcnt(0)" ::: "memory");
        }
    }
    __syncthreads();
}

__device__ __forceinline__ bool idle_share(int nunits, int G, int bid, int wave, int& w0, int& nw) {
    const int maxU = (nunits + G - 1) / G, first_idle = nunits - (maxU - 1) * G;
    if (first_idle >= G) { w0 = bid * NWAVES + wave; nw = G * NWAVES; return true; }
    if (bid < first_idle) return false;
    w0 = (bid - first_idle) * NWAVES + wave; nw = (G - first_idle) * NWAVES; return true;
}
struct Args { const float* in[18]; float* out; unsigned char* ws; float inv_freq[8]; int ph_lo, ph_hi; };
constexpr int N_PHASES = 14;

__global__ void __launch_bounds__(NTHREADS, 2) fwd_kernel(Args args) {
    extern __shared__ __attribute__((aligned(16))) unsigned char lds_raw[];
    LAS unsigned char* lds = (LAS unsigned char*)lds_raw;
    const int tid = threadIdx.x, lane = tid & 63, wave = __builtin_amdgcn_readfirstlane(tid >> 6);
    const int G = gridDim.x, bid = blockIdx.x;
    const int gw = bid * NWAVES + wave, NGW = G * NWAVES;
#define x (args.in[0])
#define c (args.in[1])
#define w_ada (args.in[2])
#define b_ada (args.in[3])
#define ln_g (args.in[4])
#define ln_b (args.in[5])
#define w_ffn1_in (args.in[6])
#define w_ffn1_out (args.in[7])
#define w_in (args.in[8])
#define b_in (args.in[9])
#define w_pool (args.in[10])
#define pool_scale (args.in[11])
#define sinks (args.in[12])
#define w_branch_a (args.in[13])
#define w_branch_b (args.in[14])
#define w_out (args.in[15])
#define w_ffn2_in (args.in[16])
#define w_ffn2_out (args.in[17])
#define out (args.out)
#define WSP(T, off) ((T*)(args.ws + (off)))
#define MOD WSP(float, WS_MOD)
#define ROPE WSP(float, WS_ROPE)
#define WGU1 WSP(bf16_t, WS_WGU1)
#define WD1 WSP(bf16_t, WS_WD1)
#define WGU2 WSP(bf16_t, WS_WGU2)
#define WD2 WSP(bf16_t, WS_WD2)
#define WIN WSP(bf16_t, WS_WIN)
#define WP WSP(bf16_t, WS_WP)
#define WA WSP(bf16_t, WS_WA)
#define WB WSP(bf16_t, WS_WB)
#define WO WSP(bf16_t, WS_WO)
#define U WSP(bf16_t, WS_U)
#define MERGED WSP(bf16_t, WS_U)
#define H WSP(bf16_t, WS_BIG)
#define XP WSP(bf16_t, WS_XP)
#define Q WSP(bf16_t, WS_Q)
#define KB WSP(bf16_t, WS_K)
#define VB WSP(bf16_t, WS_V)
#define POOLED WSP(bf16_t, WS_POOLED)
#define MIXED WSP(bf16_t, WS_MIXED)
#define OB WSP(bf16_t, WS_O)
#define SGA WSP(bf16_t, WS_SGA)
#define SGB WSP(bf16_t, WS_SGB)
    const int lo = args.ph_lo, hi = args.ph_hi;
#if MK_ONE_LAUNCH
    volatile LAS unsigned* MISC = (volatile LAS unsigned*)(lds + 131072 + 320);
    if (tid < 32) MISC[tid] = 0u;
    __syncthreads();
    XcdBarrier bar = xcd_barrier_post((unsigned*)(args.ws + WS_BAR), MISC + 8);
    if (hi > 1000) cg::this_grid().sync();
#endif
#ifndef MK_PHASES
#define MK_PHASES 0x3fff
#endif
#define IN(k) (((MK_PHASES >> (k)) & 1) && lo <= (k) && (k) < hi)
#if MK_ONE_LAUNCH
#define SEAM(k) do { if (IN(k) && IN((k) + 1)) xcd_barrier(bar); } while (0)
#else
#define SEAM(k) do { } while (0)
#endif
#define GEMM(EPI, g, S, E) pg8::gemm_phase<EPI, pg8::StaticOrder, true, true>(lds, g, S, E)

    if (IN(0)) {
        LAS float* cact = (LAS float*)lds;
        LAS float* red = (LAS float*)(lds + 32768);
        for (int i = tid; i < BATCH * D; i += NTHREADS) cact[i] = silu_f(c[i]);
        __syncthreads();
        for (int item = bid; item < 256; item += G) {
            const int col0 = item * 72, rsub = lane / 18, cl = lane - rsub * 18;
            f32x4 a0 = {0.f, 0.f, 0.f, 0.f}, a1 = a0, a2 = a0, a3 = a0;
            if (lane < 54) {
                const float* wp = w_ada + col0 + 4 * cl;
#pragma unroll 8
                for (int k = wave * 256 + rsub; k < wave * 256 + 256; k += 3) { const f32x4 wv = *(const f32x4*)(wp + (size_t)k * NMOD);
                    a0 += wv * cact[k]; a1 += wv * cact[D + k]; a2 += wv * cact[2 * D + k]; a3 += wv * cact[3 * D + k]; }
                LAS float* rp = red + ((wave * 3 + rsub) * 4) * 72 + 4 * cl;
                *(LAS f32x4*)(rp) = a0; *(LAS f32x4*)(rp + 72) = a1; *(LAS f32x4*)(rp + 144) = a2; *(LAS f32x4*)(rp + 216) = a3;
            }
            __syncthreads();
            if (tid < 288) { const int b = tid / 72, cc = tid - b * 72; float s = b_ada[col0 + cc];
                for (int p = 0; p < 24; ++p) s += red[(p * 4 + b) * 72 + cc];
                MOD[(size_t)b * NMOD + col0 + cc] = s; }
            __syncthreads();
        }
        for (int i = bid * NTHREADS + tid; i < SEQ * 8; i += G * NTHREADS) { const int pos = i >> 3, j = i & 7; const float ang = (float)pos * args.inv_freq[j];
            ROPE[pos * 16 + j] = cosf(ang); ROPE[pos * 16 + 8 + j] = sinf(ang); }
        __syncthreads();
        LAS float* scr = (LAS float*)(lds + wave * 16384);
        constexpr int I_GU = (D / 64) * (NGU / 32), I_IN = (D / 64) * (INW / 32), I_P = 4 * 8, I_BR = (1024 / 64) * (D / 32), I_O = (D / 64) * (D / 32);
        constexpr int NITEMS = I_GU + I_IN + 4 * I_P + 2 * I_BR + I_O;
        for (int it = gw; it < NITEMS; it += NGW) {
            int r = it;
            if (r < I_GU) { transpose_gu(w_ffn1_in, WGU1, r, scr, lane); continue; } r -= I_GU;
            if (r < I_IN) { transpose_plain(w_in, D, INW, WIN, r, scr, lane); continue; } r -= I_IN;
            if (r < 4 * I_P) { const int g = r / I_P; transpose_plain(w_pool + (size_t)g * 65536, 256, 256, WP + (size_t)g * 65536, r - g * I_P, scr, lane); continue; } r -= 4 * I_P;
            if (r < I_BR) { transpose_plain(w_branch_a, 1024, D, WA, r, scr, lane); continue; } r -= I_BR;
            if (r < I_BR) { transpose_plain(w_branch_b, 1024, D, WB, r, scr, lane); continue; } r -= I_BR;
            transpose_plain(w_out, D, D, WO, r, scr, lane);
        }
        __syncthreads();
    }
    SEAM(0);
    if (IN(1)) row_phase<0>(x, nullptr, U, nullptr, nullptr, MOD + 0 * D, MOD + 1 * D, gw, NGW, lane);
    SEAM(1);
    if (IN(2)) { { pg8::Gemm g{U, WGU1, D, D, D, 0}; pg8::StaticOrder S; S.init(M, NGU, G, bid); EpiSwiglu E{H}; GEMM(EpiSwiglu, g, S, E); }
        int w0, nw; if (idle_share((M / 256) * (NGU / 256), G, bid, wave, w0, nw)) { LAS float* scr = (LAS float*)(lds + wave * 16384);
            for (int it = w0; it < (DFF / 64) * (D / 32); it += nw) transpose_plain(w_ffn1_out, DFF, D, WD1, it, scr, lane); } }
    SEAM(2);
    if (IN(3)) { pg8::Gemm g{H, WD1, DFF, DFF, DFF, 0}; pg8::StaticOrder S; S.init(M, D, G, bid); EpiResid E{x, out, MOD + 2 * D, 0.5f}; GEMM(EpiResid, g, S, E); }
    SEAM(3);
    if (IN(4)) row_phase<1>(out, out, U, ln_g, ln_b, MOD + 3 * D, MOD + 4 * D, gw, NGW, lane);
    SEAM(4);
    if (IN(5)) { { pg8::Gemm g{U, WIN, D, D, D, 0}; pg8::StaticOrder S; S.init(M, INW, G, bid); EpiInProj E{b_in, ROPE, XP, Q, KB, VB, SGA, SGB}; GEMM(EpiInProj, g, S, E); }
        int w0, nw; if (idle_share((M / 256) * (INW / 256), G, bid, wave, w0, nw)) { LAS float* scr = (LAS float*)(lds + wave * 16384);
            constexpr int I_GU = (D / 64) * (NGU / 32), I_DN = (DFF / 64) * (D / 32);
            for (int it = w0; it < I_GU + I_DN; it += nw) { if (it < I_GU) transpose_gu(w_ffn2_in, WGU2, it, scr, lane); else transpose_plain(w_ffn2_out, DFF, D, WD2, it - I_GU, scr, lane); } } }
    SEAM(5);
    if (IN(6)) { attn_phase(lds, Q, KB, VB, OB, sinks, G, bid); pool_phase(XP, POOLED, gw, NGW, lane); }
    SEAM(6);
    if (IN(7)) { int kp = 256; asm volatile("" : "+s"(kp)); pg8::Gemm g{POOLED, WP, PW, 256, kp, 512}; pg8::StaticOrder S; S.init(M, PW, G, bid); EpiPool E{MIXED, pool_scale}; GEMM(EpiPool, g, S, E); }
    SEAM(7);
    if (IN(8)) {
        { pg8::Gemm g{MIXED, WA, PW, PW, PW, 0}; pg8::StaticOrder S; S.init(M, D, G, bid); EpiGate<0> E{SGA, nullptr, nullptr}; GEMM(EpiGate<0>, g, S, E); }
        { pg8::Gemm g{OB, WB, AW, AW, AW, 0}; pg8::StaticOrder S; S.init(M, D, G, bid); EpiGate<1> E{SGB, SGA, MERGED}; GEMM(EpiGate<1>, g, S, E); }
    }
    SEAM(8);
    if (IN(9)) { pg8::Gemm g{MERGED, WO, D, D, D, 0}; pg8::StaticOrder S; S.init(M, D, G, bid); EpiResid E{out, out, MOD + 5 * D, 1.0f}; GEMM(EpiResid, g, S, E); }
    SEAM(9);
    if (IN(10)) row_phase<1>(out, out, U, ln_g + D, ln_b + D, MOD + 6 * D, MOD + 7 * D, gw, NGW, lane);
    SEAM(10);
    if (IN(11)) { pg8::Gemm g{U, WGU2, D, D, D, 0}; pg8::StaticOrder S; S.init(M, NGU, G, bid); EpiSwiglu E{H}; GEMM(EpiSwiglu, g, S, E); }
    SEAM(11);
    if (IN(12)) { pg8::Gemm g{H, WD2, DFF, DFF, DFF, 0}; pg8::StaticOrder S; S.init(M, D, G, bid); EpiResid E{out, out, MOD + 8 * D, 0.5f}; GEMM(EpiResid, g, S, E); }
    SEAM(12);
    if (IN(13)) row_phase<2>(out, out, nullptr, ln_g + 2 * D, ln_b + 2 * D, nullptr, nullptr, gw, NGW, lane);
#undef IN
#undef SEAM
#undef GEMM
#undef x
#undef c
#undef w_ada
#undef b_ada
#undef ln_g
#undef ln_b
#undef w_ffn1_in
#undef w_ffn1_out
#undef w_in
#undef b_in
#undef w_pool
#undef pool_scale
#undef sinks
#undef w_branch_a
#undef w_branch_b
#undef w_out
#undef w_ffn2_in
#undef w_ffn2_out
#undef out
#undef WSP
#undef MOD
#undef ROPE
#undef WGU1
#undef WD1
#undef WGU2
#undef WD2
#undef WIN
#undef WP
#undef WA
#undef WB
#undef WO
#undef U
#undef MERGED
#undef H
#undef XP
#undef Q
#undef KB
#undef VB
#undef POOLED
#undef MIXED
#undef OB
#undef SGA
#undef SGB
}
}

extern "C" void kernel_launch(void* const* d_in, const int* in_sizes, int n_in, void* d_out, int out_size, void* d_ws, size_t ws_size, hipStream_t stream) {
    using namespace mk;
    static int grid = 0;
    if (grid == 0) {
        if (n_in != 18 || in_sizes[0] != M * D || out_size != M * D || ws_size < WS_END) { fprintf(stderr, "kernel_launch: unexpected shapes (n_in %d, in0 %d, out %d, ws %zu < %zu)\n", n_in, n_in > 0 ? in_sizes[0] : -1, out_size, ws_size, (size_t)WS_END); grid = -1; return; }
        int dev = 0, cus = 0, per_cu = 0;
        if (hipGetDevice(&dev) != hipSuccess || hipDeviceGetAttribute(&cus, hipDeviceAttributeMultiprocessorCount, dev) != hipSuccess) { grid = -1; return; }
        if (hipFuncSetAttribute((const void*)fwd_kernel, hipFuncAttributeMaxDynamicSharedMemorySize, LDS_BYTES) != hipSuccess) { fprintf(stderr, "kernel_launch: hipFuncSetAttribute failed\n"); grid = -1; return; }
        if (hipOccupancyMaxActiveBlocksPerMultiprocessor(&per_cu, (const void*)fwd_kernel, NTHREADS, LDS_BYTES) != hipSuccess || per_cu < 1) { fprintf(stderr, "kernel_launch: occupancy query says %d\n", per_cu); per_cu = 1; }
        (void)hipGetLastError();
        grid = cus * per_cu;
    }
    if (grid < 0) return;
    Args a{};
    for (int i = 0; i < 18; ++i) a.in[i] = (const float*)d_in[i];
    a.out = (float*)d_out; a.ws = (unsigned char*)d_ws;
    for (int j = 0; j < 8; ++j) a.inv_freq[j] = (float)pow(500000.0, -(double)j / 8.0);
#if MK_ONE_LAUNCH
    a.ph_lo = 0; a.ph_hi = N_PHASES;
    if (hipMemsetAsync((char*)d_ws + WS_BAR, 0, WS_BAR_BYTES, stream) != hipSuccess) { fprintf(stderr, "kernel_launch: memset of the barrier words failed\n"); return; }
    void* kargs[] = {&a};
    hipError_t e = hipLaunchCooperativeKernel((const void*)fwd_kernel, dim3(grid), dim3(NTHREADS), kargs, LDS_BYTES, stream);
    if (e != hipSuccess) fprintf(stderr, "kernel_launch: cooperative launch failed: %s (grid %d)\n", hipGetErrorString(e), grid);
#else
    for (int p = 0; p < N_PHASES; ++p) for (int rep = 0; rep < ((MK_REPEAT_MASK >> p) & 1) + 1; ++rep) { a.ph_lo = p; a.ph_hi = p + 1; hipLaunchKernelGGL(fwd_kernel, dim3(grid), dim3(NTHREADS), LDS_BYTES, stream, a); }
#endif
}
```
